# Optimizing an MI355X kernel written in HIP

```python
import math
import jax
import jax.numpy as jnp
from jax import lax
import numpy as np

D_MODEL = 2048
BATCH = 1
SEQ = 8192
DEPTH = 2

MEM_LEN = 256
HEAD_DIM = 128
N_MIX_HEADS = D_MODEL // HEAD_DIM
MEM_HEADS = 4
MEM_W = MEM_HEADS * HEAD_DIM
ATTN_GROUPS = ((128, 1), (512, 4), (2048, 16))
ATTN_HEADS = N_MIX_HEADS - MEM_HEADS
HEADS_PER_GROUP = ATTN_HEADS // len(ATTN_GROUPS)
ATTN_W = ATTN_HEADS * HEAD_DIM
ATTN_OUT_W = HEADS_PER_GROUP * HEAD_DIM
BLK = 128
SGU_GROUPS = ATTN_HEADS
SGU_GROUP_DIM = HEAD_DIM
SGU_W = SGU_GROUPS * SGU_GROUP_DIM
SGU_CHUNK = 128
ROT_DIM = HEAD_DIM // 4
ROPE_THETA = 500000.0
FFN_HIDDEN = ((8 * D_MODEL // 3 + 255) // 256) * 256
NORM_EPS = 1e-6
LN_EPS = 1e-5
NEG_INF = -1e30

kernel_name = 'hybrid_dilated_attn_gmlp_memory_trunk'


def _rms_norm(x, g):
    xf = x.astype(jnp.float32)
    y = xf * lax.rsqrt(jnp.mean(xf * xf, axis=-1, keepdims=True) + NORM_EPS)
    return (y * g.astype(jnp.float32)).astype(x.dtype)


def _layer_norm(x, g, b):
    xf = x.astype(jnp.float32)
    mu = jnp.mean(xf, axis=-1, keepdims=True)
    var = jnp.mean(jnp.square(xf - mu), axis=-1, keepdims=True)
    y = (xf - mu) * lax.rsqrt(var + LN_EPS)
    return (y * g.astype(jnp.float32) + b.astype(jnp.float32)).astype(x.dtype)


def _partial_rotary(t, positions):
    half = ROT_DIM // 2
    inv_freq = ROPE_THETA ** (-jnp.arange(half, dtype=jnp.float32) / half)
    ang = positions.astype(jnp.float32)[:, :, None] * inv_freq
    cos = jnp.cos(ang)[:, :, None, :]
    sin = jnp.sin(ang)[:, :, None, :]
    tf = t.astype(jnp.float32)
    x1 = tf[..., :half]
    x2 = tf[..., half:ROT_DIM]
    rot = jnp.concatenate([x1 * cos - x2 * sin, x2 * cos + x1 * sin, tf[..., ROT_DIM:]], axis=-1)
    return rot.astype(t.dtype)


def _dilated_group(q, k, v, window, dilation):
    b, s, h, dh = q.shape
    n_back = window // dilation
    span = dilation * BLK
    sp = -(-s // span) * span
    length = sp // dilation
    nb = length // BLK

    def to_blocks(t):
        t = jnp.pad(t, ((0, 0), (0, sp - s), (0, 0), (0, 0)))
        t = t.reshape(b, length, dilation, h, dh).transpose(0, 2, 3, 1, 4)
        return t.reshape(b, dilation, h, nb, BLK, dh)

    def with_prev(t):
        prev = jnp.pad(t[:, :, :, :-1], ((0, 0), (0, 0), (0, 0), (1, 0), (0, 0), (0, 0)))
        return jnp.concatenate([prev, t], axis=4)

    qb = to_blocks(q)
    kb = with_prev(to_blocks(k))
    vb = with_prev(to_blocks(v))
    logits = jnp.einsum('brhnqd,brhnkd->brhnqk', qb, kb,
                        preferred_element_type=jnp.float32) * (dh ** -0.5)
    qi = jnp.arange(BLK)[:, None]
    ki = jnp.arange(2 * BLK)[None, :]
    dist = BLK + qi - ki
    band = (dist >= 0) & (dist <= n_back)
    first = (jnp.arange(nb) == 0)[:, None, None]
    mask = band[None] & (jnp.logical_not(first) | (ki >= BLK)[None])
    logits = jnp.where(mask, logits, NEG_INF)
    lse = jax.nn.logsumexp(logits, axis=-1)
    p = jnp.exp(logits - lse[..., None])
    out = jnp.einsum('brhnqk,brhnkd->brhnqd', p.astype(v.dtype), vb)
    out = out.reshape(b, dilation, h, length, dh).transpose(0, 3, 1, 2, 4).reshape(b, sp, h, dh)[:, :s]
    lse = lse.reshape(b, dilation, h, length).transpose(0, 3, 1, 2).reshape(b, sp, h)[:, :s]
    return out, lse


def _dilated_attention_mixer(h, positions, w_in):
    b, s, _ = h.shape
    proj = h @ w_in
    q, k, v, q_mem = jnp.split(proj, [ATTN_W, 2 * ATTN_W, 3 * ATTN_W], axis=-1)
    q = _partial_rotary(q.reshape(b, s, ATTN_HEADS, HEAD_DIM), positions)
    k = _partial_rotary(k.reshape(b, s, ATTN_HEADS, HEAD_DIM), positions)
    v = v.reshape(b, s, ATTN_HEADS, HEAD_DIM)
    outs, lses = [], []
    for g, (window, dilation) in enumerate(ATTN_GROUPS):
        sl = slice(g * HEADS_PER_GROUP, (g + 1) * HEADS_PER_GROUP)
        o, l = _dilated_group(q[:, :, sl], k[:, :, sl], v[:, :, sl], window, dilation)
        outs.append(o)
        lses.append(l)
    w = jax.nn.softmax(jnp.stack(lses, axis=0), axis=0)
    merged = jnp.einsum('gbsh,gbshd->bshd', w.astype(v.dtype), jnp.stack(outs, axis=0))
    return merged.reshape(b, s, ATTN_OUT_W), q_mem


def _spatial_gating_mixer(h, w_in, ln_g, ln_b, w_spatial, b_spatial):
    b, s, _ = h.shape
    proj = h @ w_in
    u, v, q_mem = jnp.split(proj, [SGU_W, 2 * SGU_W], axis=-1)
    u = jax.nn.gelu(u)
    v = _layer_norm(jax.nn.gelu(v), ln_g, ln_b)
    v = v.reshape(b, s // SGU_CHUNK, SGU_CHUNK, SGU_GROUPS, SGU_GROUP_DIM)
    causal = jnp.tril(jnp.ones((SGU_CHUNK, SGU_CHUNK), dtype=bool))
    w_s = jnp.where(causal[None], w_spatial, 0.0).astype(v.dtype)
    mixed = jnp.einsum('gts,bnsgc->bntgc', w_s, v) + b_spatial.T[None, None, :, :, None]
    return u * mixed.reshape(b, s, SGU_W), q_mem


def _memory_attention(q_mem, mem_n, w_mem_kv):
    b, s, _ = q_mem.shape
    kv = mem_n @ w_mem_kv
    k, v = jnp.split(kv, 2, axis=-1)
    q = q_mem.reshape(b, s, MEM_HEADS, HEAD_DIM)
    k = k.reshape(b, -1, MEM_HEADS, HEAD_DIM)
    v = v.reshape(b, -1, MEM_HEADS, HEAD_DIM)
    logits = jnp.einsum('bshd,bmhd->bhsm', q, k,
                        preferred_element_type=jnp.float32) * (HEAD_DIM ** -0.5)
    p = jax.nn.softmax(logits, axis=-1)
    out = jnp.einsum('bhsm,bmhd->bshd', p.astype(v.dtype), v)
    return out.reshape(b, s, MEM_W)


def _swiglu(h, w_gate, w_up, w_down):
    return (jax.nn.silu(h @ w_gate) * (h @ w_up)) @ w_down


def setup_inputs(seed: int = 0) -> dict:
    key = jax.random.key(seed)
    ks = jax.random.split(key, 24)
    n_a = (DEPTH + 1) // 2
    n_b = DEPTH // 2

    def dense(k, shape, fan_in):
        return jax.random.normal(k, shape, jnp.float32) * (fan_in ** -0.5)

    def gain(k, shape):
        return 1.0 + 0.02 * jax.random.normal(k, shape, jnp.float32)

    def small(k, shape):
        return 0.02 * jax.random.normal(k, shape, jnp.float32)

    x = jax.random.normal(ks[0], (BATCH, SEQ, D_MODEL), jnp.float32)
    mem = jax.random.normal(ks[1], (BATCH, MEM_LEN, D_MODEL), jnp.float32)
    offset = jax.random.randint(ks[2], (BATCH, 1), 0, 4096, dtype=jnp.int32)
    positions = offset + jnp.arange(SEQ, dtype=jnp.int32)[None, :]
    return {
        'x': x,
        'mem': mem,
        'positions': positions,
        'mix_norm': gain(ks[3], (DEPTH, D_MODEL)),
        'mem_norm': gain(ks[4], (DEPTH, D_MODEL)),
        'w_mem_kv': dense(ks[5], (DEPTH, D_MODEL, 2 * MEM_W), D_MODEL),
        'ffn_norm': gain(ks[6], (DEPTH, D_MODEL)),
        'w_gate': dense(ks[7], (DEPTH, D_MODEL, FFN_HIDDEN), D_MODEL),
        'w_up': dense(ks[8], (DEPTH, D_MODEL, FFN_HIDDEN), D_MODEL),
        'w_down': dense(ks[9], (DEPTH, FFN_HIDDEN, D_MODEL), FFN_HIDDEN),
        'attn_w_in': dense(ks[10], (n_a, D_MODEL, 3 * ATTN_W + MEM_W), D_MODEL),
        'attn_w_out': dense(ks[11], (n_a, ATTN_OUT_W + MEM_W, D_MODEL), ATTN_OUT_W + MEM_W),
        'sgu_w_in': dense(ks[12], (n_b, D_MODEL, 2 * SGU_W + MEM_W), D_MODEL),
        'sgu_ln_g': gain(ks[13], (n_b, SGU_W)),
        'sgu_ln_b': small(ks[14], (n_b, SGU_W)),
        'sgu_w_spatial': dense(ks[15], (n_b, SGU_GROUPS, SGU_CHUNK, SGU_CHUNK), SGU_CHUNK),
        'sgu_b_spatial': gain(ks[16], (n_b, SGU_GROUPS, SGU_CHUNK)),
        'sgu_w_out': dense(ks[17], (n_b, SGU_W + MEM_W, D_MODEL), SGU_W + MEM_W),
        'final_norm': gain(ks[18], (D_MODEL,)),
    }


def reference(x, mem, positions, mix_norm, mem_norm, w_mem_kv, ffn_norm, w_gate, w_up, w_down,
              attn_w_in, attn_w_out, sgu_w_in, sgu_ln_g, sgu_ln_b, sgu_w_spatial, sgu_b_spatial,
              sgu_w_out, final_norm):
    for i in range(DEPTH):
        j = i // 2
        h = _rms_norm(x, mix_norm[i])
        if i % 2 == 0:
            mix_out, q_mem = _dilated_attention_mixer(h, positions, attn_w_in[j])
            w_out = attn_w_out[j]
        else:
            mix_out, q_mem = _spatial_gating_mixer(h, sgu_w_in[j], sgu_ln_g[j], sgu_ln_b[j],
                                                   sgu_w_spatial[j], sgu_b_spatial[j])
            w_out = sgu_w_out[j]
        mem_out = _memory_attention(q_mem, _rms_norm(mem, mem_norm[i]), w_mem_kv[i])
        x = x + jnp.concatenate([mix_out, mem_out], axis=-1) @ w_out
        x = x + _swiglu(_rms_norm(x, ffn_norm[i]), w_gate[i], w_up[i], w_down[i])
    return _rms_norm(x, final_norm)
```

```cpp
#include <hip/hip_runtime.h>
#include <hip/hip_cooperative_groups.h>
#include <cstdio>
#include <cstddef>
namespace cg = cooperative_groups;

#define LAS __attribute__((address_space(3)))
typedef unsigned short bf16_t;
typedef short bf16x8 __attribute__((ext_vector_type(8)));
typedef short bf16x4 __attribute__((ext_vector_type(4)));
typedef float f32x4 __attribute__((ext_vector_type(4)));
typedef float f32x2 __attribute__((ext_vector_type(2)));
typedef unsigned u32x4 __attribute__((ext_vector_type(4)));
typedef unsigned u32x2 __attribute__((ext_vector_type(2)));

constexpr int SEQ = 8192, DM = 2048, FF = 5632;
constexpr int NIN0 = 5120, NIN1 = 3584;
constexpr int LDS_CTL = 140288;
constexpr int LDS_BYTES = LDS_CTL + 16;

constexpr size_t O_BAR = 0;
constexpr size_t BAR_BYTES = 16384;
constexpr size_t O_WIN0 = O_BAR + BAR_BYTES;
constexpr size_t O_WOUT0 = O_WIN0 + (size_t)5120 * 2048 * 2;
constexpr size_t O_WIN1 = O_WOUT0 + (size_t)2048 * 1024 * 2;
constexpr size_t O_WOUT1 = O_WIN1 + (size_t)3584 * 2048 * 2;
constexpr size_t O_WGU = O_WOUT1 + (size_t)2048 * 2048 * 2;
constexpr size_t O_WDN = O_WGU + (size_t)2 * 11264 * 2048 * 2;
constexpr size_t O_WKV = O_WDN + (size_t)2 * 2048 * 5632 * 2;
constexpr size_t O_WSP = O_WKV + (size_t)2 * 1024 * 2048 * 2;
constexpr size_t O_H = O_WSP + (size_t)12 * 128 * 128 * 2;
constexpr size_t O_BIG = O_H + (size_t)8192 * 2048 * 2;
constexpr size_t O_CAT = O_BIG + (size_t)8192 * 5632 * 2;
constexpr size_t O_LSE = O_CAT + (size_t)8192 * 2048 * 2;
constexpr size_t O_MEMN = O_LSE + (size_t)3 * 8192 * 4 * 4;
constexpr size_t O_MEMKV = O_MEMN + (size_t)512 * 2048 * 2;
constexpr size_t O_ROPE = O_MEMKV + (size_t)512 * 2048 * 2;
constexpr size_t O_STATS = O_ROPE + (size_t)8192 * 16 * 2 * 4;
constexpr size_t O_SS = O_STATS + (size_t)8192 * 2 * 4;
constexpr size_t WS_NEED = O_SS + (size_t)4 * 8192 * 4;
static_assert(WS_NEED < 459000000ull, "workspace map too large");

struct Params {
    const float* x; const float* mem; const int* pos;
    const float* mix_norm; const float* mem_norm; const float* w_mem_kv; const float* ffn_norm;
    const float* w_gate; const float* w_up; const float* w_down;
    const float* attn_w_in; const float* attn_w_out; const float* sgu_w_in; const float* sgu_ln_g; const float* sgu_ln_b;
    const float* sgu_w_spatial; const float* sgu_b_spatial; const float* sgu_w_out; const float* final_norm;
    float* out; unsigned char* ws;
};

#define LDS_WAIT() asm volatile("s_waitcnt lgkmcnt(0)" ::: "memory")
__device__ __forceinline__ unsigned cvt_pk_bf16(float lo, float hi) { unsigned r; asm volatile("v_cvt_pk_bf16_f32 %0, %1, %2" : "=v"(r) : "v"(lo), "v"(hi)); return r; }
__device__ __forceinline__ float bf_lo(unsigned w) { return __uint_as_float(w << 16); }
__device__ __forceinline__ float bf_hi(unsigned w) { return __uint_as_float(w & 0xffff0000u); }
typedef unsigned u64;
__device__ __forceinline__ void fx_add(u64* p, float v) { atomicAdd(p, __float2uint_rn(v * 16384.0f)); }
__device__ __forceinline__ float fx_get(const u64* p) { return (float)(*p) * (1.0f / 16384.0f); }
__device__ __forceinline__ void fs_add(u64* p, float v) { atomicAdd((int*)p, __float2int_rn(v * 65536.0f)); }
__device__ __forceinline__ float fs_get(const u64* p) { return (float)(*(const int*)p) * (1.0f / 65536.0f); }
__device__ __forceinline__ float wave_sum(float v) {
#pragma unroll
    for (int o = 1; o < 64; o <<= 1) v += __shfl_xor(v, o);
    return v;
}
__device__ __forceinline__ float gelu_tanh(float x) {
    const float z2 = 1.5957691216057308f * (x + 0.044715f * x * x * x);
    return x * __builtin_amdgcn_rcpf(1.0f + __expf(-z2));
}
__device__ __forceinline__ float silu(float x) { return x * __builtin_amdgcn_rcpf(1.0f + __expf(-x)); }

namespace pg8 {
constexpr int BM = 256, BK = 64, HALF = 128, HTB = HALF * BK * 2, STAGE_BYTES = 8 * HTB, NXCD = 8, WGM = 4;
__device__ __forceinline__ int lds_byte(int r, int c) { const int st = (r >> 4) * 2 + (c >> 5), rr = r & 15, cc = c & 31, ob = rr * 64 + cc * 2; return st * 1024 + (ob ^ (((ob >> 9) & 1) << 5)); }
__device__ __forceinline__ void stage_rc(int b, int& R, int& C) { const int st = b / 1024, sb = b % 1024, swz = sb ^ (((sb >> 9) & 1) << 5); R = (st >> 1) * 16 + swz / 64; C = (st & 1) * 32 + (swz % 64) / 2; }
__device__ __forceinline__ int perm32(int rho) { const int n = rho >> 4, i = rho & 15; return 8 * (i >> 2) + 4 * n + (i & 3); }

struct Unit { int pm, pn; };
struct Gemm { const bf16_t* A; const bf16_t* Bt; int M, N, K; };
struct Order {
    int nM, nN, nwg, G, c, mode;
    __device__ void init(int M, int N, int G_, int c_, int mode_) { nM = M / BM; nN = N / BM; nwg = nM * nN; G = G_; c = c_; mode = mode_; }
    __device__ bool next(int i, Unit& u) const {
        if (mode == 1) { if (i != 0 || c < 128 || c >= 136) return false; u.pm = (c - 128) >> 2; u.pn = ((c - 128) & 3) + 4 * u.pm; return true; }
        const long L = (long)i * G + c; if (L >= nwg) return false;
        int wgid = (int)L; { const int q = nwg / NXCD, r = nwg % NXCD, xcd = wgid % NXCD, off = wgid / NXCD; wgid = (xcd < r ? xcd * (q + 1) : r * (q + 1) + (xcd - r) * q) + off; }
        const int nig = WGM * nN, gid = wgid / nig, fm = gid * WGM, gsz = (nM - fm) < WGM ? (nM - fm) : WGM;
        u.pm = fm + ((wgid % nig) % gsz); u.pn = (wgid % nig) / gsz; return true;
    }
};

struct EpiBf {
    static constexpr bool PERM = true;
    bf16_t* O; int ldc; int n_rot, n_gelu, st_lo, st_hi; const float* rope; u64* stats; const u64* ss;
    __device__ __forceinline__ void operator()(const f32x4 (&acc)[2][2][4][2], const Unit& u, int wr, int wc, int fr, int fq) const {
        const int row0 = u.pm * BM + wr * 64 + fr, col0 = u.pn * BM + wc * 32 + 8 * fq;
        const bool rot = (u.pn < n_rot) && (wc == 0), gel = u.pn < n_gelu, st = (u.pn >= st_lo) && (u.pn < st_hi);
        const float sgn = (fq < 2) ? -1.0f : 1.0f;
        float rstd[8];
#pragma unroll
        for (int i = 0; i < 8; ++i) rstd[i] = ss ? fx_get(ss + row0 + (i >> 2) * HALF + (i & 3) * 16) : 0.f;
#pragma unroll
        for (int i = 0; i < 8; ++i) rstd[i] = ss ? rsqrtf(rstd[i] * (1.0f / 2048.0f) + 1e-6f) : 1.0f;
#pragma unroll
        for (int ai = 0; ai < 2; ++ai)
#pragma unroll
            for (int m = 0; m < 4; ++m) {
                const int i = ai * 4 + m, row = row0 + ai * HALF + m * 16;
                f32x4 cs[4];
                if (rot) {
                    const f32x4* rp = (const f32x4*)(rope + (size_t)row * 32 + 16 * (fq & 1));
#pragma unroll
                    for (int q = 0; q < 4; ++q) cs[q] = rp[q];
                }
                float rs = 0.f, rq = 0.f;
#pragma unroll
                for (int bj = 0; bj < 2; ++bj) {
                    float v[8];
#pragma unroll
                    for (int j = 0; j < 4; ++j) { v[j] = acc[ai][bj][m][0][j] * rstd[i]; v[4 + j] = acc[ai][bj][m][1][j] * rstd[i]; }
                    if (rot) {
#pragma unroll
                        for (int e = 0; e < 8; ++e) {
                            const float p = __shfl_xor(v[e], 32);
                            const float c = cs[e >> 1][(e & 1) * 2], sn = cs[e >> 1][(e & 1) * 2 + 1];
                            v[e] = v[e] * c + sgn * p * sn;
                        }
                    }
                    if (gel) {
#pragma unroll
                        for (int e = 0; e < 8; ++e) v[e] = gelu_tanh(v[e]);
                    }
                    if (st) {
#pragma unroll
                        for (int e = 0; e < 8; ++e) { rs += v[e]; rq += v[e] * v[e]; }
                    }
                    u32x4 w; w.x = cvt_pk_bf16(v[0], v[1]); w.y = cvt_pk_bf16(v[2], v[3]); w.z = cvt_pk_bf16(v[4], v[5]); w.w = cvt_pk_bf16(v[6], v[7]);
                    *(u32x4*)(O + (size_t)row * ldc + col0 + bj * HALF) = w;
                }
                if (st) {
                    rs += __shfl_xor(rs, 16); rs += __shfl_xor(rs, 32);
                    rq += __shfl_xor(rq, 16); rq += __shfl_xor(rq, 32);
                    if (fq == 0) { fs_add(stats + 2 * row, rs); fs_add(stats + 2 * row + 1, rq); }
                }
            }
    }
};
struct EpiRes {
    static constexpr bool PERM = true;
    const float* base32; bf16_t* xb; u64* ss;
    __device__ __forceinline__ void load32(f32x4 (&b)[2][2], size_t off) const {
#pragma unroll
        for (int bj = 0; bj < 2; ++bj)
#pragma unroll
            for (int n = 0; n < 2; ++n) b[bj][n] = *(const f32x4*)(base32 + off + bj * HALF + n * 4);
    }
    __device__ __forceinline__ void operator()(const f32x4 (&acc)[2][2][4][2], const Unit& u, int wr, int wc, int fr, int fq) const {
        const int row0 = u.pm * BM + wr * 64 + fr, col0 = u.pn * BM + wc * 32 + 8 * fq;
        f32x4 b[2][2], bn[2][2];
        if (base32) load32(bn, (size_t)row0 * 2048 + col0);
#pragma unroll
        for (int ai = 0; ai < 2; ++ai) {
#pragma unroll
            for (int m = 0; m < 4; ++m) {
                const int row = row0 + ai * HALF + m * 16;
                const size_t off = (size_t)row * 2048 + col0;
                if (base32) {
#pragma unroll
                    for (int bj = 0; bj < 2; ++bj)
#pragma unroll
                        for (int n = 0; n < 2; ++n) b[bj][n] = bn[bj][n];
                    const int i1 = ai * 4 + m + 1;
                    if (i1 < 8) load32(bn, (size_t)(row0 + (i1 >> 2) * HALF + (i1 & 3) * 16) * 2048 + col0);
                } else {
#pragma unroll
                    for (int bj = 0; bj < 2; ++bj) { const u32x4 w = *(const u32x4*)(xb + off + bj * HALF);
                        b[bj][0] = (f32x4){bf_lo(w.x), bf_hi(w.x), bf_lo(w.y), bf_hi(w.y)}; b[bj][1] = (f32x4){bf_lo(w.z), bf_hi(w.z), bf_lo(w.w), bf_hi(w.w)}; }
                }
                float q = 0.f;
#pragma unroll
                for (int bj = 0; bj < 2; ++bj) {
                    const f32x4 v0 = b[bj][0] + acc[ai][bj][m][0], v1 = b[bj][1] + acc[ai][bj][m][1];
                    q += (v0.x * v0.x + v0.y * v0.y) + (v0.z * v0.z + v0.w * v0.w) + (v1.x * v1.x + v1.y * v1.y) + (v1.z * v1.z + v1.w * v1.w);
                    u32x4 w; w.x = cvt_pk_bf16(v0.x, v0.y); w.y = cvt_pk_bf16(v0.z, v0.w); w.z = cvt_pk_bf16(v1.x, v1.y); w.w = cvt_pk_bf16(v1.z, v1.w);
                    *(u32x4*)(xb + off + bj * HALF) = w;
                }
                if (ss) { q += __shfl_xor(q, 16); q += __shfl_xor(q, 32); if (fq == 0) fx_add(ss + row, q); }
            }
        }
    }
};
struct EpiGU {
    static constexpr bool PERM = true;
    bf16_t* O; const u64* ss;
    __device__ __forceinline__ void operator()(const f32x4 (&acc)[2][2][4][2], const Unit& u, int wr, int wc, int fr, int fq) const {
        const int row0 = u.pm * BM + wr * 64 + fr, col0 = u.pn * HALF + wc * 32 + 8 * fq;
        float rs8[8];
#pragma unroll
        for (int i = 0; i < 8; ++i) rs8[i] = fx_get(ss + row0 + (i >> 2) * HALF + (i & 3) * 16);
#pragma unroll
        for (int ai = 0; ai < 2; ++ai)
#pragma unroll
            for (int m = 0; m < 4; ++m) {
                const float rstd = rsqrtf(rs8[ai * 4 + m] * (1.0f / 2048.0f) + 1e-6f);
                float v[8];
#pragma unroll
                for (int n = 0; n < 2; ++n)
#pragma unroll
                    for (int j = 0; j < 4; ++j) v[4 * n + j] = silu(acc[ai][0][m][n][j] * rstd) * (acc[ai][1][m][n][j] * rstd);
                u32x4 w; w.x = cvt_pk_bf16(v[0], v[1]); w.y = cvt_pk_bf16(v[2], v[3]); w.z = cvt_pk_bf16(v[4], v[5]); w.w = cvt_pk_bf16(v[6], v[7]);
                *(u32x4*)(O + (size_t)(row0 + ai * HALF + m * 16) * FF + col0) = w;
            }
    }
};

template <class Epi, bool ALIGN_EPI = true, bool SP2 = true>
__device__ __forceinline__ void gemm_phase(LAS unsigned char* lds, const Gemm g, const Order& S, const Epi& E) {
    const int tid = threadIdx.x, wid = __builtin_amdgcn_readfirstlane(tid >> 6), lane = tid & 63, wr = wid >> 2, wc = wid & 3, fr = lane & 15, fq = lane >> 4;
    const int K = g.K, nt = K / BK;
    unsigned voffA[2], voffB[2];
#pragma unroll
    for (int i = 0; i < 2; ++i) { int R, C; stage_rc(tid * 16 + i * 8192, R, C); const int Rb = Epi::PERM ? ((R & ~31) + perm32(R & 31)) : R;
        voffA[i] = (unsigned)(R * K + C) * 2u; voffB[i] = (unsigned)(Rb * K + C) * 2u; }
    const unsigned kstep = (unsigned)(BK * 2);
    const unsigned hstep = (unsigned)HALF * (unsigned)K * 2u;
    const unsigned tstep = 2u * hstep;
    const __amdgpu_buffer_rsrc_t rA = __builtin_amdgcn_make_buffer_rsrc((void*)g.A, (short)0, (int)((unsigned)g.M * (unsigned)K * 2u), 0x00020000);
    const __amdgpu_buffer_rsrc_t rB = __builtin_amdgcn_make_buffer_rsrc((void*)g.Bt, (short)0, (int)((unsigned)g.N * (unsigned)K * 2u), 0x00020000);
    const unsigned ldsw = (unsigned)wid * 1024u;
    const int aoff = lds_byte(wr * 64 + fr, fq * 8), boff = lds_byte(wc * 32 + fr, fq * 8);
#define PG8_SA(b, h) (((b) * 2 + (h)) * HTB)
#define PG8_SB(b, h) ((4 + (b) * 2 + (h)) * HTB)
#define PG8_STAGE(bufoff, rsrc, soff, voff) do { _Pragma("unroll") for (int _i = 0; _i < 2; ++_i) \
        __builtin_amdgcn_raw_ptr_buffer_load_lds((rsrc), (LAS unsigned*)(lds + (bufoff) + ldsw + _i * 8192), 16, (int)(voff)[_i], (int)(soff), 0, 0); } while (0)
#define PG8_LDA(dst, b, h) do { _Pragma("unroll") for (int m = 0; m < 4; ++m) _Pragma("unroll") for (int k = 0; k < 2; ++k) dst[m][k] = *(const LAS bf16x8*)(lds + PG8_SA(b, h) + aoff + m * 2048 + k * 1024); } while (0)
#define PG8_LDB(dst, b, h) do { _Pragma("unroll") for (int n = 0; n < 2; ++n) _Pragma("unroll") for (int k = 0; k < 2; ++k) dst[n][k] = *(const LAS bf16x8*)(lds + PG8_SB(b, h) + boff + n * 2048 + k * 1024); } while (0)
#define PG8_MMA(ai, bj, At, Bt) do { __builtin_amdgcn_s_setprio(1); _Pragma("unroll") for (int m = 0; m < 4; ++m) _Pragma("unroll") for (int n = 0; n < 2; ++n) _Pragma("unroll") for (int k = 0; k < 2; ++k) \
        acc[ai][bj][m][n] = __builtin_amdgcn_mfma_f32_16x16x32_bf16(Bt[n][k], At[m][k], acc[ai][bj][m][n], 0, 0, 0); __builtin_amdgcn_s_setprio(0); } while (0)
#define PG8_WAIT_V(n) asm volatile("s_waitcnt vmcnt(" #n ")" ::: "memory")
#define PG8_WAIT_L(n) asm volatile("s_waitcnt lgkmcnt(" #n ")" ::: "memory")
#define PG8_BAR __builtin_amdgcn_s_barrier()
#define PG8_SCHED __builtin_amdgcn_sched_barrier(0)
    Unit cur, nxt; int ui = 0;
    if (!S.next(0, cur)) return;
    f32x4 acc[2][2][4][2];
#pragma unroll
    for (int a = 0; a < 2; ++a)
#pragma unroll
        for (int b = 0; b < 2; ++b)
#pragma unroll
            for (int m = 0; m < 4; ++m)
#pragma unroll
                for (int n = 0; n < 2; ++n) acc[a][b][m][n] = (f32x4){0.f, 0.f, 0.f, 0.f};
    bf16x8 At[4][2], B0[2][2], B1[2][2];
    unsigned cA = (unsigned)cur.pm * tstep, cB = (unsigned)cur.pn * tstep;
    if constexpr (SP2) {
        PG8_STAGE(PG8_SB(0, 0), rB, cB, voffB); PG8_STAGE(PG8_SB(0, 1), rB, cB + hstep, voffB); PG8_STAGE(PG8_SA(0, 0), rA, cA, voffA); PG8_STAGE(PG8_SA(0, 1), rA, cA + hstep, voffA);
        if (wr == 1) PG8_BAR;
        PG8_WAIT_V(2); PG8_BAR;
        PG8_STAGE(PG8_SB(1, 0), rB, cB + kstep, voffB); PG8_STAGE(PG8_SA(1, 0), rA, cA + kstep, voffA); PG8_STAGE(PG8_SB(1, 1), rB, cB + hstep + kstep, voffB);
        PG8_WAIT_V(6); PG8_BAR;
    } else {
        PG8_STAGE(PG8_SB(0, 0), rB, cB, voffB); PG8_STAGE(PG8_SA(0, 0), rA, cA, voffA); PG8_STAGE(PG8_SB(0, 1), rB, cB + hstep, voffB); PG8_STAGE(PG8_SA(0, 1), rA, cA + hstep, voffA);
        if (wr == 1) PG8_BAR;
        PG8_WAIT_V(4); PG8_BAR;
        PG8_STAGE(PG8_SB(1, 0), rB, cB + kstep, voffB); PG8_STAGE(PG8_SA(1, 0), rA, cA + kstep, voffA); PG8_STAGE(PG8_SB(1, 1), rB, cB + hstep + kstep, voffB);
        PG8_WAIT_V(6); PG8_BAR;
    }
    for (;;) {
        const bool has_next = S.next(ui + 1, nxt);
        const unsigned nA = has_next ? (unsigned)nxt.pm * tstep : cA, nB = has_next ? (unsigned)nxt.pn * tstep : cB;
        for (int t = 0; t < nt; t += 2) {
            const bool last = (t == nt - 2);
            const unsigned a1 = cA + (unsigned)(t + 1) * kstep;
            const unsigned a2 = last ? nA : cA + (unsigned)(t + 2) * kstep, b2 = last ? nB : cB + (unsigned)(t + 2) * kstep;
            const unsigned a3 = a2 + kstep, b3 = b2 + kstep;
            if constexpr (SP2) {
            PG8_LDB(B0, 0, 0); PG8_LDB(B1, 0, 1); PG8_SCHED; PG8_LDA(At, 0, 0); PG8_STAGE(PG8_SA(1, 1), rA, a1 + hstep, voffA);
            PG8_WAIT_V(8); PG8_WAIT_L(0); PG8_BAR; PG8_MMA(0, 0, At, B0); PG8_MMA(0, 1, At, B1); PG8_BAR; PG8_SCHED;
            PG8_LDA(At, 0, 1); PG8_STAGE(PG8_SB(0, 0), rB, b2, voffB); PG8_STAGE(PG8_SB(0, 1), rB, b2 + hstep, voffB); PG8_STAGE(PG8_SA(0, 0), rA, a2, voffA);
            PG8_WAIT_V(8); PG8_WAIT_L(0); PG8_BAR; PG8_MMA(1, 0, At, B0); PG8_MMA(1, 1, At, B1); PG8_BAR; PG8_SCHED;
            PG8_LDB(B0, 1, 0); PG8_LDB(B1, 1, 1); PG8_SCHED; PG8_LDA(At, 1, 0); PG8_STAGE(PG8_SA(0, 1), rA, a2 + hstep, voffA);
            PG8_WAIT_V(8); PG8_WAIT_L(0); PG8_BAR; PG8_MMA(0, 0, At, B0); PG8_MMA(0, 1, At, B1); PG8_BAR; PG8_SCHED;
            PG8_LDA(At, 1, 1); PG8_STAGE(PG8_SB(1, 0), rB, b3, voffB); PG8_STAGE(PG8_SB(1, 1), rB, b3 + hstep, voffB); PG8_STAGE(PG8_SA(1, 0), rA, a3, voffA);
            PG8_WAIT_V(8); PG8_WAIT_L(0); PG8_BAR; PG8_MMA(1, 0, At, B0); PG8_MMA(1, 1, At, B1); PG8_BAR; PG8_SCHED;
            } else {
            PG8_LDB(B0, 0, 0); PG8_SCHED; PG8_LDA(At, 0, 0); PG8_STAGE(PG8_SA(1, 1), rA, a1 + hstep, voffA);
            PG8_WAIT_L(8); PG8_BAR; PG8_WAIT_L(0); PG8_MMA(0, 0, At, B0); PG8_BAR; PG8_SCHED;
            PG8_LDB(B1, 0, 1); PG8_STAGE(PG8_SB(0, 0), rB, b2, voffB);
            PG8_BAR; PG8_WAIT_L(0); PG8_MMA(0, 1, At, B1); PG8_BAR;
            PG8_LDA(At, 0, 1); PG8_STAGE(PG8_SA(0, 0), rA, a2, voffA);
            PG8_BAR; PG8_WAIT_L(0); PG8_MMA(1, 0, At, B0); PG8_BAR; PG8_SCHED;
            PG8_STAGE(PG8_SB(0, 1), rB, b2 + hstep, voffB);
            PG8_WAIT_V(6); PG8_BAR; PG8_MMA(1, 1, At, B1); PG8_BAR;
            PG8_LDB(B0, 1, 0); PG8_SCHED; PG8_LDA(At, 1, 0); PG8_STAGE(PG8_SA(0, 1), rA, a2 + hstep, voffA);
            PG8_WAIT_L(8); PG8_BAR; PG8_WAIT_L(0); PG8_MMA(0, 0, At, B0); PG8_BAR; PG8_SCHED;
            PG8_LDB(B1, 1, 1); PG8_STAGE(PG8_SB(1, 0), rB, b3, voffB);
            PG8_BAR; PG8_WAIT_L(0); PG8_MMA(0, 1, At, B1); PG8_BAR;
            PG8_LDA(At, 1, 1); PG8_STAGE(PG8_SA(1, 0), rA, a3, voffA);
            PG8_BAR; PG8_WAIT_L(0); PG8_MMA(1, 0, At, B0); PG8_BAR; PG8_SCHED;
            PG8_STAGE(PG8_SB(1, 1), rB, b3 + hstep, voffB);
            PG8_WAIT_V(6); PG8_BAR; PG8_MMA(1, 1, At, B1); PG8_BAR;
            }
        }
        if constexpr (ALIGN_EPI) { if (wr == 0) PG8_BAR; }
        { int fr_e = (int)(threadIdx.x & 15u), fq_e = (int)((threadIdx.x >> 4) & 3u);
          asm volatile("" : "+v"(fr_e), "+v"(fq_e));
          E(acc, cur, wr, wc, fr_e, fq_e); }
        if (!has_next) break;
#pragma unroll
        for (int a = 0; a < 2; ++a)
#pragma unroll
            for (int b = 0; b < 2; ++b)
#pragma unroll
                for (int m = 0; m < 4; ++m)
#pragma unroll
                    for (int n = 0; n < 2; ++n) acc[a][b][m][n] = (f32x4){0.f, 0.f, 0.f, 0.f};
        cur = nxt; cA = nA; cB = nB; ++ui;
        if constexpr (ALIGN_EPI) { if (wr == 1) PG8_BAR; }
    }
    PG8_WAIT_V(0);
    if constexpr (!ALIGN_EPI) { if (wr == 0) PG8_BAR; }
    PG8_BAR;
#undef PG8_SA
#undef PG8_SB
#undef PG8_STAGE
#undef PG8_LDA
#undef PG8_LDB
#undef PG8_MMA
#undef PG8_WAIT_V
#undef PG8_WAIT_L
#undef PG8_BAR
#undef PG8_SCHED
}
}

constexpr int CV_PREP = 11456, CV_S7 = 13696, CV_S5 = 18176, CV_S1 = 20992, CV_END = 23808;
struct TileDesc { const float* src; bf16_t* dst; const float* gk; int N, K; };
__device__ __forceinline__ TileDesc tile_make(const float* W, int K, int N, bf16_t* WT, int mode, int r, const float* gain) {
    const int nblk = N >> 6, kb = r / nblk, nb = r - kb * nblk, n0 = nb * 64, k0 = kb * 64;
    int drow0 = n0;
    if (mode) drow0 = 256 * (n0 >> 7) + (n0 & 127) + (mode == 2 ? 128 : 0);
    TileDesc d; d.src = W + (size_t)k0 * N + n0; d.dst = WT + (size_t)drow0 * K + k0; d.gk = gain ? gain + k0 : nullptr; d.N = N; d.K = K; return d;
}
__device__ __forceinline__ TileDesc tile_decode(const Params __attribute__((address_space(4)))* pp, unsigned char* ws, int it) {
    constexpr int TG = 2816;
    int r = it;
    if (r < 2560) return tile_make(pp->attn_w_in, 2048, 5120, (bf16_t*)(ws + O_WIN0), 0, r, nullptr); r -= 2560;
    if (r < 512) return tile_make(pp->attn_w_out, 1024, 2048, (bf16_t*)(ws + O_WOUT0), 0, r, nullptr); r -= 512;
    if (r < 1024) { const int l = r >> 9; return tile_make(pp->w_mem_kv + (size_t)l * 2048 * 1024, 2048, 1024, (bf16_t*)(ws + O_WKV) + (size_t)l * 1024 * 2048, 0, r & 511, nullptr); } r -= 1024;
    if (r < TG) return tile_make(pp->w_gate, 2048, 5632, (bf16_t*)(ws + O_WGU), 1, r, pp->ffn_norm); r -= TG;
    if (r < TG) return tile_make(pp->w_up, 2048, 5632, (bf16_t*)(ws + O_WGU), 2, r, pp->ffn_norm); r -= TG;
    if (r < TG) return tile_make(pp->w_up + (size_t)2048 * 5632, 2048, 5632, (bf16_t*)(ws + O_WGU) + (size_t)11264 * 2048, 2, r, pp->ffn_norm + DM); r -= TG;
    if (r < TG) return tile_make(pp->w_gate + (size_t)2048 * 5632, 2048, 5632, (bf16_t*)(ws + O_WGU) + (size_t)11264 * 2048, 1, r, pp->ffn_norm + DM); r -= TG;
    if (r < 1792) return tile_make(pp->sgu_w_in, 2048, 3584, (bf16_t*)(ws + O_WIN1), 0, r, pp->mix_norm + DM); r -= 1792;
    if (r < 1024) return tile_make(pp->sgu_w_out, 2048, 2048, (bf16_t*)(ws + O_WOUT1), 0, r, nullptr); r -= 1024;
    if (r < TG) return tile_make(pp->w_down, 5632, 2048, (bf16_t*)(ws + O_WDN), 0, r, nullptr); r -= TG;
    return tile_make(pp->w_down + (size_t)5632 * 2048, 5632, 2048, (bf16_t*)(ws + O_WDN) + (size_t)2048 * 5632, 0, r, nullptr);
}
__device__ __forceinline__ void tile_load(const TileDesc& d, f32x4 (&v)[16], int lane) {
    const float* p = d.src + (size_t)(lane >> 4) * d.N + 4 * (lane & 15);
#pragma unroll
    for (int i = 0; i < 16; ++i) v[i] = *(const f32x4*)(p + (size_t)(4 * i) * d.N);
}
__device__ __forceinline__ void tile_store(const TileDesc& d, const f32x4 (&v)[16], LAS float* scr, int lane) {
    const int r4 = lane >> 4, c4 = lane & 15;
#pragma unroll
    for (int i = 0; i < 16; ++i) {
        const float gg = d.gk ? d.gk[4 * i + r4] : 1.0f;
        LAS float* q = scr + (4 * i + r4) * 65 + 4 * c4;
        q[0] = v[i].x * gg; q[1] = v[i].y * gg; q[2] = v[i].z * gg; q[3] = v[i].w * gg;
    }
    LDS_WAIT();
    const int c = lane & 7;
#pragma unroll
    for (int j = 0; j < 8; ++j) {
        const int n = (lane >> 3) + 8 * j; const LAS float* s = scr + (8 * c) * 65 + n;
        u32x4 o; o.x = cvt_pk_bf16(s[0 * 65], s[1 * 65]); o.y = cvt_pk_bf16(s[2 * 65], s[3 * 65]); o.z = cvt_pk_bf16(s[4 * 65], s[5 * 65]); o.w = cvt_pk_bf16(s[6 * 65], s[7 * 65]);
        *(u32x4*)(d.dst + (size_t)n * d.K + 8 * c) = o;
    }
    LDS_WAIT();
}
__device__ __forceinline__ void convert_tiles(const Params __attribute__((address_space(4)))* pp, unsigned char* ws, int lo, int hi, int w0, int nw, LAS float* scr, int lane) {
    int it = lo + w0;
    if (it >= hi) return;
    TileDesc d0 = tile_decode(pp, ws, it);
    f32x4 v[16], vn[16];
    tile_load(d0, v, lane);
    for (;;) {
        const int it1 = it + nw; const bool has = it1 < hi;
        TileDesc d1 = d0;
        if (has) { d1 = tile_decode(pp, ws, it1); tile_load(d1, vn, lane); }
        tile_store(d0, v, scr, lane);
        if (!has) break;
#pragma unroll
        for (int i = 0; i < 16; ++i) v[i] = vn[i];
        d0 = d1; it = it1;
    }
}
__device__ __forceinline__ void rms_row(const float* xrow, const float* g, bf16_t* obf, float* of32, int lane) {
    const f32x4* xr = (const f32x4*)xrow + lane; const f32x4* gr = (const f32x4*)g + lane;
    f32x4 v[8]; float s = 0.f;
#pragma unroll
    for (int j = 0; j < 8; ++j) { v[j] = xr[64 * j]; s += (v[j].x * v[j].x + v[j].y * v[j].y) + (v[j].z * v[j].z + v[j].w * v[j].w); }
    const float rstd = rsqrtf(wave_sum(s) * (1.0f / 2048.0f) + 1e-6f);
    if (obf) {
        u32x2* o8 = (u32x2*)obf + lane;
#pragma unroll
        for (int j = 0; j < 8; ++j) { const f32x4 gg = gr[64 * j]; const f32x4 o = v[j] * rstd * gg; u32x2 w; w.x = cvt_pk_bf16(o.x, o.y); w.y = cvt_pk_bf16(o.z, o.w); o8[64 * j] = w; }
    } else {
        f32x4* o16 = (f32x4*)of32 + lane;
#pragma unroll
        for (int j = 0; j < 8; ++j) { const f32x4 gg = gr[64 * j]; o16[64 * j] = v[j] * rstd * gg; }
    }
}

constexpr int KS_PITCH = 272, VT_PITCH = 528, VT_OFF = 256 * KS_PITCH;
struct HalfRegs { u32x4 k[4]; u32x4 va[2], vb[2]; };
__device__ __forceinline__ void half_fetch(HalfRegs& h, const bf16_t* kp, const bf16_t* vp, unsigned kvs, int tid) {
    const int wid = tid >> 6, lane = tid & 63;
    { const int ch = tid & 15, r0 = tid >> 4;
#pragma unroll
      for (int i = 0; i < 4; ++i) h.k[i] = *(const u32x4*)(kp + (size_t)(r0 + 32 * i) * kvs + 8 * ch); }
    { const int cl = lane & 3, pair = (lane >> 2) + 16 * (wid & 3);
      const bf16_t* v0 = vp + (size_t)(2 * pair) * kvs;
#pragma unroll
      for (int i = 0; i < 2; ++i) { const int c = cl + 4 * ((wid >> 2) + 2 * i); h.va[i] = *(const u32x4*)(v0 + 8 * c); h.vb[i] = *(const u32x4*)(v0 + kvs + 8 * c); } }
}
__device__ __forceinline__ void half_commit(const HalfRegs& h, LAS unsigned char* lds, int slot, int tid) {
    const int wid = tid >> 6, lane = tid & 63;
    LAS unsigned char* Ks = lds + slot * (128 * KS_PITCH);
    LAS unsigned char* Vt = lds + VT_OFF + slot * 256;
    { const int ch = tid & 15, r0 = tid >> 4;
#pragma unroll
      for (int i = 0; i < 4; ++i) *(LAS u32x4*)(Ks + (r0 + 32 * i) * KS_PITCH + ch * 16) = h.k[i]; }
    { const int cl = lane & 3, pair = (lane >> 2) + 16 * (wid & 3);
#pragma unroll
      for (int i = 0; i < 2; ++i) { const int c = cl + 4 * ((wid >> 2) + 2 * i); const u32x4 a = h.va[i], b = h.vb[i];
          LAS unsigned char* dst = Vt + (8 * c) * VT_PITCH + 4 * pair;
          *(LAS unsigned*)(dst + 0 * VT_PITCH) = (a.x & 0xffffu) | (b.x << 16);
          *(LAS unsigned*)(dst + 1 * VT_PITCH) = (a.x >> 16) | (b.x & 0xffff0000u);
          *(LAS unsigned*)(dst + 2 * VT_PITCH) = (a.y & 0xffffu) | (b.y << 16);
          *(LAS unsigned*)(dst + 3 * VT_PITCH) = (a.y >> 16) | (b.y & 0xffff0000u);
          *(LAS unsigned*)(dst + 4 * VT_PITCH) = (a.z & 0xffffu) | (b.z << 16);
          *(LAS unsigned*)(dst + 5 * VT_PITCH) = (a.z >> 16) | (b.z & 0xffff0000u);
          *(LAS unsigned*)(dst + 6 * VT_PITCH) = (a.w & 0xffffu) | (b.w << 16);
          *(LAS unsigned*)(dst + 7 * VT_PITCH) = (a.w >> 16) | (b.w & 0xffff0000u); } }
}
__device__ __forceinline__ void q_fetch(bf16x8 (&qf)[4], const bf16_t* qp, unsigned qs, int tid) {
    const int wid = tid >> 6, lane = tid & 63, l15 = lane & 15, quad = lane >> 4;
    const bf16_t* qrow = qp + (size_t)(16 * wid + l15) * qs + 8 * quad;
#pragma unroll
    for (int ks = 0; ks < 4; ++ks) qf[ks] = *(const bf16x8*)(qrow + 32 * ks);
}
__device__ __forceinline__ void attn_compute(LAS unsigned char* lds, const bf16x8 (&qf)[4], int p, bf16_t* op, unsigned os, float* lp, unsigned ls, bool masked, bool first, int tid) {
    const int wid = __builtin_amdgcn_readfirstlane(tid >> 6), lane = tid & 63, l15 = lane & 15, quad = lane >> 4;
    LAS unsigned char* Ks = lds;
    LAS unsigned char* Vt = lds + VT_OFF;
    f32x4 s[16];
#pragma unroll
    for (int kt = 0; kt < 16; ++kt) {
        f32x4 a = (f32x4){0.f, 0.f, 0.f, 0.f};
        if (!masked || (kt >= wid && kt <= wid + 8)) {
            const int pt = (kt + 8 * p) & 15;
#pragma unroll
            for (int ks = 0; ks < 4; ++ks) { const bf16x8 kf = *(const LAS bf16x8*)(Ks + (16 * pt + l15) * KS_PITCH + ks * 64 + quad * 16);
                a = __builtin_amdgcn_mfma_f32_16x16x32_bf16(kf, qf[ks], a, 0, 0, 0); }
        }
        s[kt] = a;
    }
    constexpr float SC = 0.08838834764831845f * 1.4426950408889634f;
    const int qi = 16 * wid + l15;
    float mx = -3.0e38f;
#pragma unroll
    for (int kt = 0; kt < 16; ++kt)
#pragma unroll
        for (int j = 0; j < 4; ++j) { const int key = 16 * kt + 4 * quad + j;
            const bool ok = !masked || (key >= qi && key <= qi + 128 && (!first || key >= 128));
            const float v = ok ? s[kt][j] * SC : -1.0e30f; s[kt][j] = v; mx = fmaxf(mx, v); }
    mx = fmaxf(mx, __shfl_xor(mx, 16)); mx = fmaxf(mx, __shfl_xor(mx, 32));
    float sum = 0.f;
#pragma unroll
    for (int kt = 0; kt < 16; ++kt)
#pragma unroll
        for (int j = 0; j < 4; ++j) { const float pp_ = __builtin_amdgcn_exp2f(s[kt][j] - mx); s[kt][j] = pp_; sum += pp_; }
    sum += __shfl_xor(sum, 16); sum += __shfl_xor(sum, 32);
    bf16x8 pb[8];
#pragma unroll
    for (int t = 0; t < 8; ++t) { u32x4 w; w.x = cvt_pk_bf16(s[2 * t][0], s[2 * t][1]); w.y = cvt_pk_bf16(s[2 * t][2], s[2 * t][3]);
        w.z = cvt_pk_bf16(s[2 * t + 1][0], s[2 * t + 1][1]); w.w = cvt_pk_bf16(s[2 * t + 1][2], s[2 * t + 1][3]); pb[t] = __builtin_bit_cast(bf16x8, w); }
    const float inv = 1.0f / sum;
    bf16_t* orow = op + (size_t)qi * os + 4 * quad;
#pragma unroll
    for (int dt = 0; dt < 8; ++dt) {
        f32x4 a = (f32x4){0.f, 0.f, 0.f, 0.f};
#pragma unroll
        for (int t = 0; t < 8; ++t) {
            if (!masked || (2 * t + 1 >= wid && 2 * t <= wid + 8)) {
                const int pt = (t + 4 * p) & 7;
                const LAS unsigned char* vr = Vt + (16 * dt + l15) * VT_PITCH + (32 * pt + 4 * quad) * 2;
                const u32x2 lo = *(const LAS u32x2*)vr, hi = *(const LAS u32x2*)(vr + 32);
                u32x4 w; w.x = lo.x; w.y = lo.y; w.z = hi.x; w.w = hi.y;
                a = __builtin_amdgcn_mfma_f32_16x16x32_bf16(__builtin_bit_cast(bf16x8, w), pb[t], a, 0, 0, 0);
            }
        }
        u32x2 w; w.x = cvt_pk_bf16(a[0] * inv, a[1] * inv); w.y = cvt_pk_bf16(a[2] * inv, a[3] * inv);
        *(u32x2*)(orow + 16 * dt) = w;
    }
    if (lp && quad == 0) lp[(size_t)qi * ls] = (mx + __log2f(sum)) * 0.6931471805599453f;
}
__device__ __forceinline__ void attn_run(LAS unsigned char* lds, int n0, int nit, const bf16_t* qp, unsigned qbs, unsigned qs, const bf16_t* kp, const bf16_t* vp, unsigned kbs, unsigned kvs,
                                         bf16_t* op, unsigned obs, unsigned os, float* lp, unsigned lbs, unsigned ls, bool masked, int tid) {
    HalfRegs hr; bf16x8 qf[4];
    __syncthreads();
    {
        HalfRegs h2;
        if (kbs == 0) {
            half_fetch(hr, kp, vp, kvs, tid); half_fetch(h2, kp + (size_t)128 * kvs, vp + (size_t)128 * kvs, kvs, tid);
            q_fetch(qf, qp + (size_t)n0 * qbs, qs, tid);
            half_commit(hr, lds, 0, tid); half_commit(h2, lds, 1, tid);
        } else {
            const int mprev = n0 > 0 ? n0 - 1 : 0;
            half_fetch(hr, kp + (size_t)mprev * kbs, vp + (size_t)mprev * kbs, kvs, tid); half_fetch(h2, kp + (size_t)n0 * kbs, vp + (size_t)n0 * kbs, kvs, tid);
            q_fetch(qf, qp + (size_t)n0 * qbs, qs, tid);
            half_commit(hr, lds, (n0 - 1) & 1, tid); half_commit(h2, lds, n0 & 1, tid);
        }
    }
    __syncthreads();
#pragma unroll 1
    for (int j = 0; j < nit; ++j) {
        const int n = n0 + j; const bool more = j + 1 < nit;
        if (more && kbs != 0) half_fetch(hr, kp + (size_t)(n + 1) * kbs, vp + (size_t)(n + 1) * kbs, kvs, tid);
        attn_compute(lds, qf, kbs == 0 ? 0 : ((n - 1) & 1), op + (size_t)n * obs, os, lp ? lp + (size_t)n * lbs : nullptr, ls, masked, masked && n == 0, tid);
        if (more) {
            __syncthreads();
            q_fetch(qf, qp + (size_t)(n + 1) * qbs, qs, tid);
            if (kbs != 0) half_commit(hr, lds, (n + 1) & 1, tid);
            __syncthreads();
        }
    }
}

struct SguRegs { u32x4 a[2], b[2]; int st[4]; bf16x8 wf[4]; };
__device__ __forceinline__ void sgu_fetch(SguRegs& R, const bf16_t* proj, const u64* stats, const bf16_t* wsp, int n, int g, int tid) {
    const int wid = tid >> 6, lane = tid & 63, l15 = lane & 15, quad = lane >> 4;
    { const bf16_t* wrow = wsp + (size_t)g * 16384 + (size_t)(16 * wid + l15) * 128 + 8 * quad;
#pragma unroll
      for (int ks = 0; ks < 4; ++ks) R.wf[ks] = *(const bf16x8*)(wrow + 32 * ks); }
    const int cl = lane & 3, pair = (lane >> 2) + 16 * (wid & 3);
    const int row0 = 128 * n + 2 * pair;
#pragma unroll
    for (int k = 0; k < 4; ++k) R.st[k] = ((const int*)stats)[2 * row0 + k];
    const bf16_t* v0 = proj + (size_t)row0 * NIN1 + 1536 + 128 * g;
#pragma unroll
    for (int i = 0; i < 2; ++i) { const int c = cl + 4 * ((wid >> 2) + 2 * i); R.a[i] = *(const u32x4*)(v0 + 8 * c); R.b[i] = *(const u32x4*)(v0 + NIN1 + 8 * c); }
}
__device__ __forceinline__ void sgu_commit(const SguRegs& R, LAS unsigned char* lds, const float* lng, const float* lnb, int g, int tid) {
    const int wid = tid >> 6, lane = tid & 63;
    LAS unsigned char* Vt = lds + VT_OFF;
    const int cl = lane & 3, pair = (lane >> 2) + 16 * (wid & 3);
    const float s0 = (float)R.st[0] * (1.0f / 65536.0f), q0 = (float)R.st[1] * (1.0f / 65536.0f), s1 = (float)R.st[2] * (1.0f / 65536.0f), q1 = (float)R.st[3] * (1.0f / 65536.0f);
    const float mu0 = s0 * (1.0f / 1536.0f), mu1 = s1 * (1.0f / 1536.0f);
    const float rs0 = rsqrtf(fmaxf(q0 * (1.0f / 1536.0f) - mu0 * mu0, 0.f) + 1e-5f), rs1 = rsqrtf(fmaxf(q1 * (1.0f / 1536.0f) - mu1 * mu1, 0.f) + 1e-5f);
#pragma unroll
    for (int i = 0; i < 2; ++i) { const int c = cl + 4 * ((wid >> 2) + 2 * i);
        const u32x4 a = R.a[i], b = R.b[i];
        const f32x4 g0 = *(const f32x4*)(lng + 128 * g + 8 * c), g1 = *(const f32x4*)(lng + 128 * g + 8 * c + 4);
        const f32x4 b0 = *(const f32x4*)(lnb + 128 * g + 8 * c), b1 = *(const f32x4*)(lnb + 128 * g + 8 * c + 4);
        const unsigned aw[4] = {a.x, a.y, a.z, a.w}, bw[4] = {b.x, b.y, b.z, b.w};
        const float gg[8] = {g0.x, g0.y, g0.z, g0.w, g1.x, g1.y, g1.z, g1.w}, bb[8] = {b0.x, b0.y, b0.z, b0.w, b1.x, b1.y, b1.z, b1.w};
        LAS unsigned char* dst = Vt + (8 * c) * VT_PITCH + 4 * pair;
#pragma unroll
        for (int e = 0; e < 8; ++e) {
            const float xa = (e & 1) ? bf_hi(aw[e >> 1]) : bf_lo(aw[e >> 1]);
            const float xb = (e & 1) ? bf_hi(bw[e >> 1]) : bf_lo(bw[e >> 1]);
            const float ya = (xa - mu0) * rs0 * gg[e] + bb[e], yb = (xb - mu1) * rs1 * gg[e] + bb[e];
            *(LAS unsigned*)(dst + e * VT_PITCH) = cvt_pk_bf16(ya, yb);
        } }
}
__device__ __forceinline__ void sgu_compute(const bf16x8 (&wf)[4], LAS unsigned char* lds, const bf16_t* proj, const float* bsp, bf16_t* cat, int n, int g, int tid) {
    const int wid = __builtin_amdgcn_readfirstlane(tid >> 6), lane = tid & 63, l15 = lane & 15, quad = lane >> 4;
    LAS unsigned char* Vt = lds + VT_OFF;
    const int t = 16 * wid + l15;
    const float bias = bsp[g * 128 + t];
    const size_t grow = (size_t)(128 * n + t);
    const bf16_t* urow = proj + grow * NIN1 + 128 * g + 4 * quad;
    bf16_t* orow = cat + grow * 2048 + 128 * g + 4 * quad;
    u32x2 uu[8];
#pragma unroll
    for (int ct = 0; ct < 8; ++ct) uu[ct] = *(const u32x2*)(urow + 16 * ct);
#pragma unroll
    for (int ct = 0; ct < 8; ++ct) {
        f32x4 a = (f32x4){0.f, 0.f, 0.f, 0.f};
#pragma unroll
        for (int ks = 0; ks < 4; ++ks) {
            if (32 * ks <= 16 * wid + 15) {
                const bf16x8 vf = *(const LAS bf16x8*)(Vt + (16 * ct + l15) * VT_PITCH + ks * 64 + quad * 16);
                a = __builtin_amdgcn_mfma_f32_16x16x32_bf16(vf, wf[ks], a, 0, 0, 0);
            }
        }
        u32x2 w; w.x = cvt_pk_bf16((a[0] + bias) * bf_lo(uu[ct].x), (a[1] + bias) * bf_hi(uu[ct].x)); w.y = cvt_pk_bf16((a[2] + bias) * bf_lo(uu[ct].y), (a[3] + bias) * bf_hi(uu[ct].y));
        *(u32x2*)(orow + 16 * ct) = w;
    }
}
__device__ __forceinline__ void sgu_run(LAS unsigned char* lds, const bf16_t* proj, const u64* stats, const float* lng, const float* lnb, const bf16_t* wsp, const float* bsp, bf16_t* cat,
                                        int it0, int stride, int nit, int tid) {
    SguRegs R;
    sgu_fetch(R, proj, stats, wsp, it0 / 12, it0 % 12, tid);
#pragma unroll 1
    for (int j = 0; j < nit; ++j) {
        const int it = it0 + j * stride, n = it / 12, g = it - 12 * n;
        __syncthreads();
        sgu_commit(R, lds, lng, lnb, g, tid);
        bf16x8 wf[4];
#pragma unroll
        for (int ks = 0; ks < 4; ++ks) wf[ks] = R.wf[ks];
        __syncthreads();
        if (j + 1 < nit) { const int itn = it + stride; sgu_fetch(R, proj, stats, wsp, itn / 12, itn % 12, tid); }
        sgu_compute(wf, lds, proj, bsp, cat, n, g, tid);
    }
}

#define XB_TMO      128
#define XB_XCNT(j)  (256  + 64 * (j))
#define XB_XSUB(j)  (1280 + 64 * (j))
#define XB_XGEN(j)  (2304 + 64 * (j))
#define XB_TOP      3328
#define XB_TOPGEN   3392
#define XCD_BAR_WORDS 3456
#define XB_SPIN_CAP (1u << 18)
__device__ __forceinline__ unsigned xb_ld(unsigned* p)              { return __hip_atomic_load(p, __ATOMIC_RELAXED, __HIP_MEMORY_SCOPE_AGENT); }
__device__ __forceinline__ unsigned xb_add(unsigned* p, unsigned v) { return __hip_atomic_fetch_add(p, v, __ATOMIC_RELAXED, __HIP_MEMORY_SCOPE_AGENT); }
__device__ __forceinline__ unsigned xb_xcc_id() { return (unsigned)__builtin_amdgcn_s_getreg((3 << 11) | 20) & 0xFu; }
#define XB_SPIN(cond, bar) do { unsigned _sp = 0; while (cond) { __builtin_amdgcn_s_sleep(1); \
    if ((++_sp & 255u) == 0u) { if (xb_ld(&(bar)[XB_TMO])) break; if (_sp > XB_SPIN_CAP) { atomicAdd(&(bar)[XB_TMO], 1u); break; } } } } while (0)
struct XcdBarrier { unsigned* bar; unsigned x; volatile LAS unsigned* st; };
__device__ __forceinline__ XcdBarrier xcd_barrier_post(unsigned* bar, volatile LAS unsigned* st) {
    XcdBarrier b; b.bar = bar; b.x = xb_xcc_id(); b.st = st;
    if (threadIdx.x == 0) (void)xb_add(&bar[XB_XCNT(b.x)], 1u);
    return b;
}
__device__ __forceinline__ void xcd_barrier_complete(unsigned* bar, unsigned x, unsigned& nloc, unsigned& nx) {
    const unsigned G = gridDim.x * gridDim.y * gridDim.z;
    unsigned sum, cnt, mine, sp = 0u;
    for (;;) {
        sum = 0u; cnt = 0u; mine = 0u;
#pragma unroll
        for (unsigned j = 0; j < 16; ++j) { const unsigned c = xb_ld(&bar[XB_XCNT(j)]); sum += c; cnt += (c > 0u) ? 1u : 0u; mine = (j == x) ? c : mine; }
        if (sum == G) break;
        __builtin_amdgcn_s_sleep(1);
        if ((++sp & 255u) == 0u) { if (xb_ld(&bar[XB_TMO])) break; if (sp > XB_SPIN_CAP) { atomicAdd(&bar[XB_TMO], 1u); break; } }
    }
    nloc = mine > 0u ? mine : 1u; nx = cnt > 0u ? cnt : 1u;
}
__device__ __forceinline__ void xcd_barrier(const XcdBarrier& b) {
    asm volatile("s_waitcnt vmcnt(0)" ::: "memory");
    __syncthreads();
    if (threadIdx.x == 0) {
        unsigned* bar = b.bar;
        __builtin_amdgcn_s_waitcnt(0);
        unsigned nloc = b.st[0], nx = b.st[1];
        if (nloc == 0u) { xcd_barrier_complete(bar, b.x, nloc, nx); b.st[0] = nloc; b.st[1] = nx; }
        const unsigned old = xb_add(&bar[XB_XSUB(b.x)], 1u);
        const unsigned gen = old / nloc;
        if (old + 1u == (gen + 1u) * nloc) {
            __builtin_amdgcn_fence(__ATOMIC_RELEASE, "agent");
            asm volatile("s_waitcnt vmcnt(0)" ::: "memory");
            const unsigned og = xb_add(&bar[XB_TOP], 1u);
            const unsigned tg = og / nx;
            if (og + 1u == (tg + 1u) * nx) xb_add(&bar[XB_TOPGEN], 1u);
            else XB_SPIN(xb_ld(&bar[XB_TOPGEN]) == tg, bar);
            __builtin_amdgcn_fence(__ATOMIC_ACQUIRE, "agent");
            xb_add(&bar[XB_XGEN(b.x)], 1u);
            asm volatile("s_waitcnt vmcnt(0)" ::: "memory");
        } else {
            XB_SPIN(xb_ld(&bar[XB_XGEN(b.x)]) == gen, bar);
            __builtin_amdgcn_fence(__ATOMIC_ACQUIRE, "agent");
            asm volatile("s_waitcnt vmcnt(0)" ::: "memory");
        }
    }
    __syncthreads();
}

enum { K_PREP = 0, K_GEMM_BF = 1, K_MIX = 2, K_MERGE = 3, K_GEMM_RES = 4, K_NORM = 5, K_GEMM_GU = 6 };
constexpr unsigned long long KINDS = 0x0ull | (1ull << 4) | (2ull << 8) | (3ull << 12) | (4ull << 16) | (6ull << 20) | (4ull << 24) | (1ull << 28) | (2ull << 32) | (4ull << 36) |
                                     (6ull << 40) | (4ull << 44) | (5ull << 48);
constexpr int NSTEPS = 13;
#ifndef ENMASK
#define ENMASK 0x7f
#endif
#ifndef REP_MASK
#define REP_MASK 0
#endif
#ifndef SYNC_REP
#define SYNC_REP 1
#endif

__global__ void __launch_bounds__(512, 2) fwd_megakernel(Params p) {
    extern __shared__ __attribute__((aligned(16))) unsigned char lds_raw[];
    LAS unsigned char* lds = (LAS unsigned char*)lds_raw;
    cg::grid_group grid = cg::this_grid();
    const int G = gridDim.x, bid = blockIdx.x;
    if (threadIdx.x < 4) ((LAS unsigned*)(lds + LDS_CTL))[threadIdx.x] = 0u;
    __syncthreads();
    if (p.ws == nullptr) grid.sync();
    const XcdBarrier xbar = xcd_barrier_post((unsigned*)(p.ws + O_BAR), (volatile LAS unsigned*)(lds + LDS_CTL));
#pragma unroll 1
    for (int step = 0; step < NSTEPS; ++step) {
        const int kind = (int)((KINDS >> (4 * step)) & 15ull);
        const int layer = (step >= 7) ? 1 : 0;
        const bool idem = (kind == K_PREP) || (kind == K_MIX) || (kind == K_MERGE) || (kind == K_NORM) || (kind == K_GEMM_GU) || (kind == K_GEMM_BF && layer == 0);
        const int nrep = (REP_MASK != 0 && ((REP_MASK >> kind) & 1) && idem) ? 2 : 1;
#pragma unroll 1
        for (int rep = 0; rep < nrep; ++rep) {
        int tid = threadIdx.x; asm volatile("" : "+v"(tid));
        const Params __attribute__((address_space(4)))* pp = (const Params __attribute__((address_space(4)))*)__builtin_amdgcn_kernarg_segment_ptr();
        asm volatile("" : "+s"(pp));
        unsigned char* ws = pp->ws;
        const int lane = tid & 63, wave = __builtin_amdgcn_readfirstlane(tid >> 6);
        bf16_t* WIN0 = (bf16_t*)(ws + O_WIN0); bf16_t* WOUT0 = (bf16_t*)(ws + O_WOUT0); bf16_t* WIN1 = (bf16_t*)(ws + O_WIN1); bf16_t* WOUT1 = (bf16_t*)(ws + O_WOUT1);
        bf16_t* WGU = (bf16_t*)(ws + O_WGU); bf16_t* WDN = (bf16_t*)(ws + O_WDN); bf16_t* WKV = (bf16_t*)(ws + O_WKV); bf16_t* WSP = (bf16_t*)(ws + O_WSP);
        bf16_t* H = (bf16_t*)(ws + O_H); bf16_t* AO = (bf16_t*)(ws + O_H); bf16_t* BIG = (bf16_t*)(ws + O_BIG); bf16_t* CAT = (bf16_t*)(ws + O_CAT);
        float* LSE = (float*)(ws + O_LSE); bf16_t* MEMN = (bf16_t*)(ws + O_MEMN); bf16_t* MEMKV = (bf16_t*)(ws + O_MEMKV); float* ROPE = (float*)(ws + O_ROPE); u64* STATS = (u64*)(ws + O_STATS); u64* SS = (u64*)(ws + O_SS);

        int cv_lo = 0, cv_hi = 0, cv_w0 = 0, cv_nw = 1;
        switch (kind) {
        case K_PREP: if constexpr ((ENMASK >> 0) & 1) {
            const int gw = bid * 8 + wave, NGW = G * 8;
            cv_lo = 0; cv_hi = CV_PREP; cv_w0 = gw; cv_nw = NGW;
            for (int m = gw; m < SEQ + 512; m += NGW) {
                if (m < SEQ) rms_row(pp->x + (size_t)m * DM, pp->mix_norm, H + (size_t)m * DM, nullptr, lane);
                else { const int mm = m - SEQ, l = mm >> 8, r = mm & 255; rms_row(pp->mem + (size_t)r * DM, pp->mem_norm + l * DM, MEMN + (size_t)mm * DM, nullptr, lane); }
            }
            const int gt = bid * 512 + tid, NGT = G * 512;
            for (int i = gt; i < SEQ * 16; i += NGT) {
                const int t = i >> 4, f = i & 15;
                const float inv = exp2f(-(float)f * 1.1832230355827609f);
                const float ang = (float)pp->pos[t] * inv;
                const float k = rintf(ang * 0.15915494309189535f);
                float r = fmaf(-k, 6.28125f, ang); r = fmaf(-k, 0.0019353071795864769f, r);
                ROPE[2 * i] = __cosf(r); ROPE[2 * i + 1] = __sinf(r);
            }
            for (int i = gt; i < SEQ * 6; i += NGT) STATS[i] = 0u;
            for (int i = gt; i < 12 * 128 * 128; i += NGT) { const int tt = (i >> 7) & 127, ss = i & 127; const float w = (ss <= tt) ? pp->sgu_w_spatial[i] : 0.f; WSP[i] = (bf16_t)(cvt_pk_bf16(w, 0.f) & 0xffffu); }
        } break;
        case K_GEMM_BF: if constexpr ((ENMASK >> 1) & 1) {
            const int nsub = layer ? 1 : 2;
#pragma unroll 1
            for (int sub = 0; sub < nsub; ++sub) {
                pg8::Gemm g; pg8::Order S; pg8::EpiBf E;
                if (layer == 0 && sub == 0) { g = pg8::Gemm{H, WIN0, SEQ, NIN0, DM}; S.init(SEQ, NIN0, G, bid, 0); E = pg8::EpiBf{BIG, NIN0, 12, 0, 0, 0, ROPE, STATS, nullptr}; }
                else if (layer == 0) { g = pg8::Gemm{MEMN, WKV, 512, 2048, DM}; S.init(512, 2048, G, bid, 1); E = pg8::EpiBf{MEMKV, 2048, 0, 0, 0, 0, ROPE, STATS, nullptr}; }
                else { g = pg8::Gemm{H, WIN1, SEQ, NIN1, DM}; S.init(SEQ, NIN1, G, bid, 0); E = pg8::EpiBf{BIG, NIN1, 0, 12, 6, 12, ROPE, STATS, SS + SEQ}; }
                pg8::gemm_phase<pg8::EpiBf>(lds, g, S, E);
            }
            if (rep == 0) {
                if (layer == 0) { if (bid >= 136) { cv_lo = CV_S5; cv_hi = CV_S1; cv_w0 = (bid - 136) * 8 + wave; cv_nw = (G - 136) * 8; } }
                else { if (bid >= 192) { cv_lo = CV_PREP; cv_hi = CV_S7; cv_w0 = (bid - 192) * 8 + wave; cv_nw = (G - 192) * 8; } }
            }
        } break;
        case K_MIX: if constexpr ((ENMASK >> 2) & 1) {
            if (layer == 0) {
                if (bid < 192) {
                    const int g = bid >> 6, rr = bid & 63, h = rr & 3, chain = rr >> 2;
                    const int d = (g == 0) ? 1 : ((g == 1) ? 4 : 16), rpr = 16 / d, r = chain / rpr, n0 = 4 * (chain - r * rpr);
                    const bf16_t* base = BIG + (size_t)r * NIN0 + (4 * g + h) * 128;
                    attn_run(lds, n0, 4, base, 128u * d * NIN0, (unsigned)d * NIN0, base + 1536, base + 3072, 128u * d * NIN0, (unsigned)d * NIN0,
                             AO + (size_t)g * SEQ * 512 + (size_t)r * 512 + h * 128, 128u * d * 512, (unsigned)d * 512,
                             LSE + (size_t)g * SEQ * 4 + (size_t)r * 4 + h, 128u * d * 4, (unsigned)d * 4, true, tid);
                } else {
                    const int mb = bid - 192, h = mb & 3, n0 = 4 * (mb >> 2);
                    const bf16_t* kv = MEMKV + h * 128;
                    attn_run(lds, n0, 4, BIG + 4608 + h * 128, 128u * NIN0, (unsigned)NIN0, kv, kv + 512, 0u, 2048u,
                             CAT + 512 + h * 128, 128u * 1024, 1024u, nullptr, 0u, 0u, false, tid);
                }
            } else {
                sgu_run(lds, BIG, STATS, pp->sgu_ln_g, pp->sgu_ln_b, WSP, pp->sgu_b_spatial, CAT, bid, G, 3, tid);
                { const int h = bid & 3, n = bid >> 2;
                  const bf16_t* kv = MEMKV + (size_t)256 * 2048 + 1024 + h * 128;
                  attn_run(lds, n, 1, BIG + 3072 + h * 128, 128u * NIN1, (unsigned)NIN1, kv, kv + 512, 0u, 2048u,
                           CAT + 1536 + h * 128, 128u * 2048, 2048u, nullptr, 0u, 0u, false, tid); }
            }
        } break;
        case K_MERGE: if constexpr ((ENMASK >> 3) & 1) {
            const int gt = bid * 512 + tid, NGT = G * 512;
#pragma unroll 1
            for (int i0 = gt; i0 < SEQ * 64; i0 += 4 * NGT) {
                float l0[4], l1[4], l2[4]; u32x4 a[4], b[4], c[4];
#pragma unroll
                for (int j = 0; j < 4; ++j) {
                    const int i = (i0 + j * NGT < SEQ * 64) ? i0 + j * NGT : i0;
                    const int t = i >> 6, rem = i & 63, h = rem >> 4, c8 = rem & 15;
                    l0[j] = LSE[(size_t)t * 4 + h]; l1[j] = LSE[(size_t)SEQ * 4 + t * 4 + h]; l2[j] = LSE[(size_t)2 * SEQ * 4 + t * 4 + h];
                    const size_t off = (size_t)t * 512 + h * 128 + c8 * 8;
                    a[j] = *(const u32x4*)(AO + off); b[j] = *(const u32x4*)(AO + (size_t)SEQ * 512 + off); c[j] = *(const u32x4*)(AO + (size_t)2 * SEQ * 512 + off);
                }
#pragma unroll
                for (int j = 0; j < 4; ++j) {
                    const int i = i0 + j * NGT;
                    if (i < SEQ * 64) {
                        const int t = i >> 6, rem = i & 63, h = rem >> 4, c8 = rem & 15;
                        const float m = fmaxf(l0[j], fmaxf(l1[j], l2[j]));
                        float w0 = __expf(l0[j] - m), w1 = __expf(l1[j] - m), w2 = __expf(l2[j] - m);
                        const float inv = 1.0f / (w0 + w1 + w2); w0 *= inv; w1 *= inv; w2 *= inv;
                        const u32x4 aa = a[j], bb = b[j], cc = c[j];
                        u32x4 o;
                        o.x = cvt_pk_bf16(w0 * bf_lo(aa.x) + w1 * bf_lo(bb.x) + w2 * bf_lo(cc.x), w0 * bf_hi(aa.x) + w1 * bf_hi(bb.x) + w2 * bf_hi(cc.x));
                        o.y = cvt_pk_bf16(w0 * bf_lo(aa.y) + w1 * bf_lo(bb.y) + w2 * bf_lo(cc.y), w0 * bf_hi(aa.y) + w1 * bf_hi(bb.y) + w2 * bf_hi(cc.y));
                        o.z = cvt_pk_bf16(w0 * bf_lo(aa.z) + w1 * bf_lo(bb.z) + w2 * bf_lo(cc.z), w0 * bf_hi(aa.z) + w1 * bf_hi(bb.z) + w2 * bf_hi(cc.z));
                        o.w = cvt_pk_bf16(w0 * bf_lo(aa.w) + w1 * bf_lo(bb.w) + w2 * bf_lo(cc.w), w0 * bf_hi(aa.w) + w1 * bf_hi(bb.w) + w2 * bf_hi(cc.w));
                        *(u32x4*)(CAT + (size_t)t * 1024 + h * 128 + c8 * 8) = o;
                    }
                }
            }
        } break;
        case K_GEMM_RES: if constexpr ((ENMASK >> 4) & 1) {
            pg8::Gemm g; pg8::EpiRes E{nullptr, H, SS};
            if (step == 4) { g = pg8::Gemm{CAT, WOUT0, SEQ, DM, 1024}; E.base32 = pp->x; }
            else if (step == 6) { g = pg8::Gemm{BIG, WDN, SEQ, DM, FF}; E.ss = SS + SEQ; }
            else if (step == 9) { g = pg8::Gemm{CAT, WOUT1, SEQ, DM, 2048}; E.ss = SS + 2 * SEQ; }
            else { g = pg8::Gemm{BIG, WDN + (size_t)2048 * 5632, SEQ, DM, FF}; E.ss = SS + 3 * SEQ; }
            pg8::Order S; S.init(SEQ, DM, G, bid, 0);
            pg8::gemm_phase<pg8::EpiRes>(lds, g, S, E);
        } break;
        case K_NORM: if constexpr ((ENMASK >> 5) & 1) {
            const int gw = bid * 8 + wave, NGW = G * 8;
            for (int m = gw; m < SEQ; m += NGW) {
                const float rstd = rsqrtf(fx_get(SS + 3 * SEQ + m) * (1.0f / 2048.0f) + 1e-6f);
                const u32x4* xr = (const u32x4*)(H + (size_t)m * DM) + lane; const f32x4* gr = (const f32x4*)pp->final_norm + 2 * lane; f32x4* orow = (f32x4*)(pp->out + (size_t)m * DM) + 2 * lane;
#pragma unroll
                for (int j = 0; j < 4; ++j) { const u32x4 w = xr[64 * j]; const f32x4 g0 = gr[128 * j], g1 = gr[128 * j + 1];
                    orow[128 * j] = (f32x4){bf_lo(w.x), bf_hi(w.x), bf_lo(w.y), bf_hi(w.y)} * rstd * g0; orow[128 * j + 1] = (f32x4){bf_lo(w.z), bf_hi(w.z), bf_lo(w.w), bf_hi(w.w)} * rstd * g1; }
            }
        } break;
        case K_GEMM_GU: if constexpr ((ENMASK >> 6) & 1) {
            pg8::Gemm g{H, WGU + (size_t)layer * 11264 * 2048, SEQ, 11264, DM};
            pg8::Order S; S.init(SEQ, 11264, G, bid, 0);
            pg8::EpiGU E{BIG, SS + (layer ? 2 * SEQ : 0)};
            pg8::gemm_phase<pg8::EpiGU>(lds, g, S, E);
            if (rep == 0 && bid >= 128) {
                if (layer == 0) { cv_lo = CV_S7; cv_hi = CV_S5; } else { cv_lo = CV_S1; cv_hi = CV_END; }
                cv_w0 = (bid - 128) * 8 + wave; cv_nw = (G - 128) * 8;
            }
        } break;
        default: break;
        }
        if (cv_hi > cv_lo) convert_tiles(pp, ws, cv_lo, cv_hi, cv_w0, cv_nw, (LAS float*)(lds + wave * 16640), lane);
        if (step + 1 < NSTEPS || rep + 1 < nrep) {
#pragma unroll 1
            for (int sr = 0; sr < SYNC_REP; ++sr) xcd_barrier(xbar);
        }
        }
    }
}

extern "C" void kernel_launch(void* const* d_in, const int* in_sizes, int n_in, void* d_out, int out_size, void* d_ws, size_t ws_size, hipStream_t stream) {
    static int grid_blocks = 0;
    if (grid_blocks == 0) {
        if (n_in != 19 || ws_size < WS_NEED || out_size != SEQ * DM) { fprintf(stderr, "kernel_launch: unexpected problem (n_in %d, ws %zu need %zu, out %d)\n", n_in, ws_size, (size_t)WS_NEED, out_size); grid_blocks = -1; return; }
        int dev = 0, cus = 0, per_cu = 0;
        (void)hipGetDevice(&dev);
        (void)hipDeviceGetAttribute(&cus, hipDeviceAttributeMultiprocessorCount, dev);
        if (hipFuncSetAttribute((const void*)fwd_megakernel, hipFuncAttributeMaxDynamicSharedMemorySize, LDS_BYTES) != hipSuccess) { fprintf(stderr, "kernel_launch: hipFuncSetAttribute failed\n"); grid_blocks = -1; return; }
        if (hipOccupancyMaxActiveBlocksPerMultiprocessor(&per_cu, (const void*)fwd_megakernel, 512, LDS_BYTES) != hipSuccess || per_cu < 1) { fprintf(stderr, "kernel_launch: occupancy query failed (%d)\n", per_cu); grid_blocks = -1; return; }
        grid_blocks = cus * 1;
    }
    if (grid_blocks < 0) return;
    Params p{};
    p.x = (const float*)d_in[0]; p.mem = (const float*)d_in[1]; p.pos = (const int*)d_in[2];
    p.mix_norm = (const float*)d_in[3]; p.mem_norm = (const float*)d_in[4]; p.w_mem_kv = (const float*)d_in[5]; p.ffn_norm = (const float*)d_in[6];
    p.w_gate = (const float*)d_in[7]; p.w_up = (const float*)d_in[8]; p.w_down = (const float*)d_in[9];
    p.attn_w_in = (const float*)d_in[10]; p.attn_w_out = (const float*)d_in[11]; p.sgu_w_in = (const float*)d_in[12]; p.sgu_ln_g = (const float*)d_in[13]; p.sgu_ln_b = (const float*)d_in[14];
    p.sgu_w_spatial = (const float*)d_in[15]; p.sgu_b_spatial = (const float*)d_in[16]; p.sgu_w_out = (const float*)d_in[17]; p.final_norm = (const float*)d_in[18];
    p.out = (float*)d_out; p.ws = (unsigned char*)d_ws;
    if (hipMemsetAsync(d_ws, 0, BAR_BYTES, stream) != hipSuccess) { fprintf(stderr, "kernel_launch: memset failed\n"); return; }
    void* args[] = {&p};
    hipError_t e = hipLaunchCooperativeKernel((const void*)fwd_megakernel, dim3(grid_blocks), dim3(512), args, LDS_BYTES, stream);
    if (e != hipSuccess) fprintf(stderr, "kernel_launch: cooperative launch failed: %s (grid %d)\n", hipGetErrorString(e), grid_blocks);
}
```

```cpp
#include <hip/hip_runtime.h>
#include <hip/hip_cooperative_groups.h>
#include <cstdio>
#include <cstddef>
namespace cg = cooperative_groups;

#define LAS __attribute__((address_space(3)))
typedef unsigned short bf16_t;
typedef short bf16x8 __attribute__((ext_vector_type(8)));
typedef short bf16x4 __attribute__((ext_vector_type(4)));
typedef float f32x4 __attribute__((ext_vector_type(4)));
typedef float f32x2 __attribute__((ext_vector_type(2)));
typedef unsigned u32x4 __attribute__((ext_vector_type(4)));
typedef unsigned u32x2 __attribute__((ext_vector_type(2)));

constexpr int SEQ = 8192, DM = 2048, FF = 5632;
constexpr int NIN0 = 5120, NIN1 = 3584;
constexpr int LDS_CTL = 140288;
constexpr int LDS_BYTES = LDS_CTL + 16;

constexpr size_t O_BAR = 0;
constexpr size_t BAR_BYTES = 16384;
constexpr size_t O_WIN0 = O_BAR + BAR_BYTES;
constexpr size_t O_WOUT0 = O_WIN0 + (size_t)5120 * 2048 * 2;
constexpr size_t O_WIN1 = O_WOUT0 + (size_t)2048 * 1024 * 2;
constexpr size_t O_WOUT1 = O_WIN1 + (size_t)3584 * 2048 * 2;
constexpr size_t O_WGU = O_WOUT1 + (size_t)2048 * 2048 * 2;
constexpr size_t O_WDN = O_WGU + (size_t)2 * 11264 * 2048 * 2;
constexpr size_t O_WKV = O_WDN + (size_t)2 * 2048 * 5632 * 2;
constexpr size_t O_WSP = O_WKV + (size_t)2 * 1024 * 2048 * 2;
constexpr size_t O_H = O_WSP + (size_t)12 * 128 * 128 * 2;
constexpr size_t O_BIG = O_H + (size_t)8192 * 2048 * 2;
constexpr size_t O_CAT = O_BIG + (size_t)8192 * 5632 * 2;
constexpr size_t O_LSE = O_CAT + (size_t)8192 * 2048 * 2;
constexpr size_t O_MEMN = O_LSE + (size_t)3 * 8192 * 4 * 4;
constexpr size_t O_MEMKV = O_MEMN + (size_t)512 * 2048 * 2;
constexpr size_t O_ROPE = O_MEMKV + (size_t)512 * 2048 * 2;
constexpr size_t O_STATS = O_ROPE + (size_t)8192 * 16 * 2 * 4;
constexpr size_t O_SS = O_STATS + (size_t)8192 * 2 * 4;
constexpr size_t WS_NEED = O_SS + (size_t)4 * 8192 * 4;
static_assert(WS_NEED < 459000000ull, "workspace map too large");

struct Params {
    const float* x; const float* mem; const int* pos;
    const float* mix_norm; const float* mem_norm; const float* w_mem_kv; const float* ffn_norm;
    const float* w_gate; const float* w_up; const float* w_down;
    const float* attn_w_in; const float* attn_w_out; const float* sgu_w_in; const float* sgu_ln_g; const float* sgu_ln_b;
    const float* sgu_w_spatial; const float* sgu_b_spatial; const float* sgu_w_out; const float* final_norm;
    float* out; unsigned char* ws;
};

#define LDS_WAIT() asm volatile("s_waitcnt lgkmcnt(0)" ::: "memory")
__device__ __forceinline__ unsigned cvt_pk_bf16(float lo, float hi) { unsigned r; asm volatile("v_cvt_pk_bf16_f32 %0, %1, %2" : "=v"(r) : "v"(lo), "v"(hi)); return r; }
__device__ __forceinline__ float bf_lo(unsigned w) { return __uint_as_float(w << 16); }
__device__ __forceinline__ float bf_hi(unsigned w) { return __uint_as_float(w & 0xffff0000u); }
typedef unsigned u64;
__device__ __forceinline__ void fx_add(u64* p, float v) { atomicAdd(p, __float2uint_rn(v * 16384.0f)); }
__device__ __forceinline__ float fx_get(const u64* p) { return (float)(*p) * (1.0f / 16384.0f); }
__device__ __forceinline__ void fs_add(u64* p, float v) { atomicAdd((int*)p, __float2int_rn(v * 65536.0f)); }
__device__ __forceinline__ float fs_get(const u64* p) { return (float)(*(const int*)p) * (1.0f / 65536.0f); }
__device__ __forceinline__ float wave_sum(float v) {
#pragma unroll
    for (int o = 1; o < 64; o <<= 1) v += __shfl_xor(v, o);
    return v;
}
__device__ __forceinline__ float gelu_tanh(float x) {
    const float z2 = 1.5957691216057308f * (x + 0.044715f * x * x * x);
    return x * __builtin_amdgcn_rcpf(1.0f + __expf(-z2));
}
__device__ __forceinline__ float silu(float x) { return x * __builtin_amdgcn_rcpf(1.0f + __expf(-x)); }

namespace pg8 {
constexpr int BM = 256, BK = 64, HALF = 128, HTB = HALF * BK * 2, STAGE_BYTES = 8 * HTB, NXCD = 8, WGM = 4;
__device__ __forceinline__ int lds_byte(int r, int c) { const int st = (r >> 4) * 2 + (c >> 5), rr = r & 15, cc = c & 31, ob = rr * 64 + cc * 2; return st * 1024 + (ob ^ (((ob >> 9) & 1) << 5)); }
__device__ __forceinline__ void stage_rc(int b, int& R, int& C) { const int st = b / 1024, sb = b % 1024, swz = sb ^ (((sb >> 9) & 1) << 5); R = (st >> 1) * 16 + swz / 64; C = (st & 1) * 32 + (swz % 64) / 2; }
__device__ __forceinline__ int perm32(int rho) { const int n = rho >> 4, i = rho & 15; return 8 * (i >> 2) + 4 * n + (i & 3); }

struct Unit { int pm, pn; };
struct Gemm { const bf16_t* A; const bf16_t* Bt; int M, N, K; };
struct Order {
    int nM, nN, nwg, G, c, mode;
    __device__ void init(int M, int N, int G_, int c_, int mode_) { nM = M / BM; nN = N / BM; nwg = nM * nN; G = G_; c = c_; mode = mode_; }
    __device__ bool next(int i, Unit& u) const {
        if (mode == 1) { if (i != 0 || c < 128 || c >= 136) return false; u.pm = (c - 128) >> 2; u.pn = ((c - 128) & 3) + 4 * u.pm; return true; }
        const long L = (long)i * G + c; if (L >= nwg) return false;
        int wgid = (int)L; { const int q = nwg / NXCD, r = nwg % NXCD, xcd = wgid % NXCD, off = wgid / NXCD; wgid = (xcd < r ? xcd * (q + 1) : r * (q + 1) + (xcd - r) * q) + off; }
        const int nig = WGM * nN, gid = wgid / nig, fm = gid * WGM, gsz = (nM - fm) < WGM ? (nM - fm) : WGM;
        u.pm = fm + ((wgid % nig) % gsz); u.pn = (wgid % nig) / gsz; return true;
    }
};

struct EpiBf {
    static constexpr bool PERM = true;
    bf16_t* O; int ldc; int n_rot, n_gelu, st_lo, st_hi; const float* rope; u64* stats; const u64* ss;
    __device__ __forceinline__ void operator()(const f32x4 (&acc)[2][2][4][2], const Unit& u, int wr, int wc, int fr, int fq) const {
        const int row0 = u.pm * BM + wr * 64 + fr, col0 = u.pn * BM + wc * 32 + 8 * fq;
        const bool rot = (u.pn < n_rot) && (wc == 0), gel = u.pn < n_gelu, st = (u.pn >= st_lo) && (u.pn < st_hi);
        const float sgn = (fq < 2) ? -1.0f : 1.0f;
        float rstd[8];
#pragma unroll
        for (int i = 0; i < 8; ++i) rstd[i] = ss ? fx_get(ss + row0 + (i >> 2) * HALF + (i & 3) * 16) : 0.f;
#pragma unroll
        for (int i = 0; i < 8; ++i) rstd[i] = ss ? rsqrtf(rstd[i] * (1.0f / 2048.0f) + 1e-6f) : 1.0f;
#pragma unroll
        for (int ai = 0; ai < 2; ++ai)
#pragma unroll
            for (int m = 0; m < 4; ++m) {
                const int i = ai * 4 + m, row = row0 + ai * HALF + m * 16;
                f32x4 cs[4];
                if (rot) {
                    const f32x4* rp = (const f32x4*)(rope + (size_t)row * 32 + 16 * (fq & 1));
#pragma unroll
                    for (int q = 0; q < 4; ++q) cs[q] = rp[q];
                }
                float rs = 0.f, rq = 0.f;
#pragma unroll
                for (int bj = 0; bj < 2; ++bj) {
                    float v[8];
#pragma unroll
                    for (int j = 0; j < 4; ++j) { v[j] = acc[ai][bj][m][0][j] * rstd[i]; v[4 + j] = acc[ai][bj][m][1][j] * rstd[i]; }
                    if (rot) {
#pragma unroll
                        for (int e = 0; e < 8; ++e) {
                            const float p = __shfl_xor(v[e], 32);
                            const float c = cs[e >> 1][(e & 1) * 2], sn = cs[e >> 1][(e & 1) * 2 + 1];
                            v[e] = v[e] * c + sgn * p * sn;
                        }
                    }
                    if (gel) {
#pragma unroll
                        for (int e = 0; e < 8; ++e) v[e] = gelu_tanh(v[e]);
                    }
                    if (st) {
#pragma unroll
                        for (int e = 0; e < 8; ++e) { rs += v[e]; rq += v[e] * v[e]; }
                    }
                    u32x4 w; w.x = cvt_pk_bf16(v[0], v[1]); w.y = cvt_pk_bf16(v[2], v[3]); w.z = cvt_pk_bf16(v[4], v[5]); w.w = cvt_pk_bf16(v[6], v[7]);
                    *(u32x4*)(O + (size_t)row * ldc + col0 + bj * HALF) = w;
                }
                if (st) {
                    rs += __shfl_xor(rs, 16); rs += __shfl_xor(rs, 32);
                    rq += __shfl_xor(rq, 16); rq += __shfl_xor(rq, 32);
                    if (fq == 0) { fs_add(stats + 2 * row, rs); fs_add(stats + 2 * row + 1, rq); }
                }
            }
    }
};
struct EpiRes {
    static constexpr bool PERM = true;
    const float* base32; bf16_t* xb; u64* ss;
    __device__ __forceinline__ void load32(f32x4 (&b)[2][2], size_t off) const {
#pragma unroll
        for (int bj = 0; bj < 2; ++bj)
#pragma unroll
            for (int n = 0; n < 2; ++n) b[bj][n] = *(const f32x4*)(base32 + off + bj * HALF + n * 4);
    }
    __device__ __forceinline__ void operator()(const f32x4 (&acc)[2][2][4][2], const Unit& u, int wr, int wc, int fr, int fq) const {
        const int row0 = u.pm * BM + wr * 64 + fr, col0 = u.pn * BM + wc * 32 + 8 * fq;
        f32x4 b[2][2], bn[2][2];
        if (base32) load32(bn, (size_t)row0 * 2048 + col0);
#pragma unroll
        for (int ai = 0; ai < 2; ++ai) {
#pragma unroll
            for (int m = 0; m < 4; ++m) {
                const int row = row0 + ai * HALF + m * 16;
                const size_t off = (size_t)row * 2048 + col0;
                if (base32) {
#pragma unroll
                    for (int bj = 0; bj < 2; ++bj)
#pragma unroll
                        for (int n = 0; n < 2; ++n) b[bj][n] = bn[bj][n];
                    const int i1 = ai * 4 + m + 1;
                    if (i1 < 8) load32(bn, (size_t)(row0 + (i1 >> 2) * HALF + (i1 & 3) * 16) * 2048 + col0);
                } else {
#pragma unroll
                    for (int bj = 0; bj < 2; ++bj) { const u32x4 w = *(const u32x4*)(xb + off + bj * HALF);
                        b[bj][0] = (f32x4){bf_lo(w.x), bf_hi(w.x), bf_lo(w.y), bf_hi(w.y)}; b[bj][1] = (f32x4){bf_lo(w.z), bf_hi(w.z), bf_lo(w.w), bf_hi(w.w)}; }
                }
                float q = 0.f;
#pragma unroll
                for (int bj = 0; bj < 2; ++bj) {
                    const f32x4 v0 = b[bj][0] + acc[ai][bj][m][0], v1 = b[bj][1] + acc[ai][bj][m][1];
                    q += (v0.x * v0.x + v0.y * v0.y) + (v0.z * v0.z + v0.w * v0.w) + (v1.x * v1.x + v1.y * v1.y) + (v1.z * v1.z + v1.w * v1.w);
                    u32x4 w; w.x = cvt_pk_bf16(v0.x, v0.y); w.y = cvt_pk_bf16(v0.z, v0.w); w.z = cvt_pk_bf16(v1.x, v1.y); w.w = cvt_pk_bf16(v1.z, v1.w);
                    *(u32x4*)(xb + off + bj * HALF) = w;
                }
                if (ss) { q += __shfl_xor(q, 16); q += __shfl_xor(q, 32); if (fq == 0) fx_add(ss + row, q); }
            }
        }
    }
};
struct EpiGU {
    static constexpr bool PERM = true;
    bf16_t* O; const u64* ss;
    __device__ __forceinline__ void operator()(const f32x4 (&acc)[2][2][4][2], const Unit& u, int wr, int wc, int fr, int fq) const {
        const int row0 = u.pm * BM + wr * 64 + fr, col0 = u.pn * HALF + wc * 32 + 8 * fq;
        float rs8[8];
#pragma unroll
        for (int i = 0; i < 8; ++i) rs8[i] = fx_get(ss + row0 + (i >> 2) * HALF + (i & 3) * 16);
#pragma unroll
        for (int ai = 0; ai < 2; ++ai)
#pragma unroll
            for (int m = 0; m < 4; ++m) {
                const float rstd = rsqrtf(rs8[ai * 4 + m] * (1.0f / 2048.0f) + 1e-6f);
                float v[8];
#pragma unroll
                for (int n = 0; n < 2; ++n)
#pragma unroll
                    for (int j = 0; j < 4; ++j) v[4 * n + j] = silu(acc[ai][0][m][n][j] * rstd) * (acc[ai][1][m][n][j] * rstd);
                u32x4 w; w.x = cvt_pk_bf16(v[0], v[1]); w.y = cvt_pk_bf16(v[2], v[3]); w.z = cvt_pk_bf16(v[4], v[5]); w.w = cvt_pk_bf16(v[6], v[7]);
                *(u32x4*)(O + (size_t)(row0 + ai * HALF + m * 16) * FF + col0) = w;
            }
    }
};

template <class Epi, bool ALIGN_EPI = true, bool SP2 = true>
__device__ __forceinline__ void gemm_phase(LAS unsigned char* lds, const Gemm g, const Order& S, const Epi& E) {
    const int tid = threadIdx.x, wid = __builtin_amdgcn_readfirstlane(tid >> 6), lane = tid & 63, wr = wid >> 2, wc = wid & 3, fr = lane & 15, fq = lane >> 4;
    const int K = g.K, nt = K / BK;
    unsigned voffA[2], voffB[2];
#pragma unroll
    for (int i = 0; i < 2; ++i) { int R, C; stage_rc(tid * 16 + i * 8192, R, C); const int Rb = Epi::PERM ? ((R & ~31) + perm32(R & 31)) : R;
        voffA[i] = (unsigned)(R * K + C) * 2u; voffB[i] = (unsigned)(Rb * K + C) * 2u; }
    const unsigned kstep = (unsigned)(BK * 2);
    const unsigned hstep = (unsigned)HALF * (unsigned)K * 2u;
    const unsigned tstep = 2u * hstep;
    const __amdgpu_buffer_rsrc_t rA = __builtin_amdgcn_make_buffer_rsrc((void*)g.A, (short)0, (int)((unsigned)g.M * (unsigned)K * 2u), 0x00020000);
    const __amdgpu_buffer_rsrc_t rB = __builtin_amdgcn_make_buffer_rsrc((void*)g.Bt, (short)0, (int)((unsigned)g.N * (unsigned)K * 2u), 0x00020000);
    const unsigned ldsw = (unsigned)wid * 1024u;
    const int aoff = lds_byte(wr * 64 + fr, fq * 8), boff = lds_byte(wc * 32 + fr, fq * 8);
#define PG8_SA(b, h) (((b) * 2 + (h)) * HTB)
#define PG8_SB(b, h) ((4 + (b) * 2 + (h)) * HTB)
#define PG8_STAGE(bufoff, rsrc, soff, voff) do { _Pragma("unroll") for (int _i = 0; _i < 2; ++_i) \
        __builtin_amdgcn_raw_ptr_buffer_load_lds((rsrc), (LAS unsigned*)(lds + (bufoff) + ldsw + _i * 8192), 16, (int)(voff)[_i], (int)(soff), 0, 0); } while (0)
#define PG8_LDA(dst, b, h) do { _Pragma("unroll") for (int m = 0; m < 4; ++m) _Pragma("unroll") for (int k = 0; k < 2; ++k) dst[m][k] = *(const LAS bf16x8*)(lds + PG8_SA(b, h) + aoff + m * 2048 + k * 1024); } while (0)
#define PG8_LDB(dst, b, h) do { _Pragma("unroll") for (int n = 0; n < 2; ++n) _Pragma("unroll") for (int k = 0; k < 2; ++k) dst[n][k] = *(const LAS bf16x8*)(lds + PG8_SB(b, h) + boff + n * 2048 + k * 1024); } while (0)
#define PG8_MMA(ai, bj, At, Bt) do { __builtin_amdgcn_s_setprio(1); _Pragma("unroll") for (int m = 0; m < 4; ++m) _Pragma("unroll") for (int n = 0; n < 2; ++n) _Pragma("unroll") for (int k = 0; k < 2; ++k) \
        acc[ai][bj][m][n] = __builtin_amdgcn_mfma_f32_16x16x32_bf16(Bt[n][k], At[m][k], acc[ai][bj][m][n], 0, 0, 0); __builtin_amdgcn_s_setprio(0); } while (0)
#define PG8_WAIT_V(n) asm volatile("s_waitcnt vmcnt(" #n ")" ::: "memory")
#define PG8_WAIT_L(n) asm volatile("s_waitcnt lgkmcnt(" #n ")" ::: "memory")
#define PG8_BAR __builtin_amdgcn_s_barrier()
#define PG8_SCHED __builtin_amdgcn_sched_barrier(0)
    Unit cur, nxt; int ui = 0;
    if (!S.next(0, cur)) return;
    f32x4 acc[2][2][4][2];
#pragma unroll
    for (int a = 0; a < 2; ++a)
#pragma unroll
        for (int b = 0; b < 2; ++b)
#pragma unroll
            for (int m = 0; m < 4; ++m)
#pragma unroll
                for (int n = 0; n < 2; ++n) acc[a][b][m][n] = (f32x4){0.f, 0.f, 0.f, 0.f};
    bf16x8 At[4][2], B0[2][2], B1[2][2];
    unsigned cA = (unsigned)cur.pm * tstep, cB = (unsigned)cur.pn * tstep;
    if constexpr (SP2) {
        PG8_STAGE(PG8_SB(0, 0), rB, cB, voffB); PG8_STAGE(PG8_SB(0, 1), rB, cB + hstep, voffB); PG8_STAGE(PG8_SA(0, 0), rA, cA, voffA); PG8_STAGE(PG8_SA(0, 1), rA, cA + hstep, voffA);
        if (wr == 1) PG8_BAR;
        PG8_WAIT_V(2); PG8_BAR;
        PG8_STAGE(PG8_SB(1, 0), rB, cB + kstep, voffB); PG8_STAGE(PG8_SA(1, 0), rA, cA + kstep, voffA); PG8_STAGE(PG8_SB(1, 1), rB, cB + hstep + kstep, voffB);
        PG8_WAIT_V(6); PG8_BAR;
    } else {
        PG8_STAGE(PG8_SB(0, 0), rB, cB, voffB); PG8_STAGE(PG8_SA(0, 0), rA, cA, voffA); PG8_STAGE(PG8_SB(0, 1), rB, cB + hstep, voffB); PG8_STAGE(PG8_SA(0, 1), rA, cA + hstep, voffA);
        if (wr == 1) PG8_BAR;
        PG8_WAIT_V(4); PG8_BAR;
        PG8_STAGE(PG8_SB(1, 0), rB, cB + kstep, voffB); PG8_STAGE(PG8_SA(1, 0), rA, cA + kstep, voffA); PG8_STAGE(PG8_SB(1, 1), rB, cB + hstep + kstep, voffB);
        PG8_WAIT_V(6); PG8_BAR;
    }
    for (;;) {
        const bool has_next = S.next(ui + 1, nxt);
        const unsigned nA = has_next ? (unsigned)nxt.pm * tstep : cA, nB = has_next ? (unsigned)nxt.pn * tstep : cB;
        for (int t = 0; t < nt; t += 2) {
            const bool last = (t == nt - 2);
            const unsigned a1 = cA + (unsigned)(t + 1) * kstep;
            const unsigned a2 = last ? nA : cA + (unsigned)(t + 2) * kstep, b2 = last ? nB : cB + (unsigned)(t + 2) * kstep;
            const unsigned a3 = a2 + kstep, b3 = b2 + kstep;
            if constexpr (SP2) {
            PG8_LDB(B0, 0, 0); PG8_LDB(B1, 0, 1); PG8_SCHED; PG8_LDA(At, 0, 0); PG8_STAGE(PG8_SA(1, 1), rA, a1 + hstep, voffA);
            PG8_WAIT_V(8); PG8_WAIT_L(0); PG8_BAR; PG8_MMA(0, 0, At, B0); PG8_MMA(0, 1, At, B1); PG8_BAR; PG8_SCHED;
            PG8_LDA(At, 0, 1); PG8_STAGE(PG8_SB(0, 0), rB, b2, voffB); PG8_STAGE(PG8_SB(0, 1), rB, b2 + hstep, voffB); PG8_STAGE(PG8_SA(0, 0), rA, a2, voffA);
            PG8_WAIT_V(8); PG8_WAIT_L(0); PG8_BAR; PG8_MMA(1, 0, At, B0); PG8_MMA(1, 1, At, B1); PG8_BAR; PG8_SCHED;
            PG8_LDB(B0, 1, 0); PG8_LDB(B1, 1, 1); PG8_SCHED; PG8_LDA(At, 1, 0); PG8_STAGE(PG8_SA(0, 1), rA, a2 + hstep, voffA);
            PG8_WAIT_V(8); PG8_WAIT_L(0); PG8_BAR; PG8_MMA(0, 0, At, B0); PG8_MMA(0, 1, At, B1); PG8_BAR; PG8_SCHED;
            PG8_LDA(At, 1, 1); PG8_STAGE(PG8_SB(1, 0), rB, b3, voffB); PG8_STAGE(PG8_SB(1, 1), rB, b3 + hstep, voffB); PG8_STAGE(PG8_SA(1, 0), rA, a3, voffA);
            PG8_WAIT_V(8); PG8_WAIT_L(0); PG8_BAR; PG8_MMA(1, 0, At, B0); PG8_MMA(1, 1, At, B1); PG8_BAR; PG8_SCHED;
            } else {
            PG8_LDB(B0, 0, 0); PG8_SCHED; PG8_LDA(At, 0, 0); PG8_STAGE(PG8_SA(1, 1), rA, a1 + hstep, voffA);
            PG8_WAIT_L(8); PG8_BAR; PG8_WAIT_L(0); PG8_MMA(0, 0, At, B0); PG8_BAR; PG8_SCHED;
            PG8_LDB(B1, 0, 1); PG8_STAGE(PG8_SB(0, 0), rB, b2, voffB);
            PG8_BAR; PG8_WAIT_L(0); PG8_MMA(0, 1, At, B1); PG8_BAR;
            PG8_LDA(At, 0, 1); PG8_STAGE(PG8_SA(0, 0), rA, a2, voffA);
            PG8_BAR; PG8_WAIT_L(0); PG8_MMA(1, 0, At, B0); PG8_BAR; PG8_SCHED;
            PG8_STAGE(PG8_SB(0, 1), rB, b2 + hstep, voffB);
            PG8_WAIT_V(6); PG8_BAR; PG8_MMA(1, 1, At, B1); PG8_BAR;
            PG8_LDB(B0, 1, 0); PG8_SCHED; PG8_LDA(At, 1, 0); PG8_STAGE(PG8_SA(0, 1), rA, a2 + hstep, voffA);
            PG8_WAIT_L(8); PG8_BAR; PG8_WAIT_L(0); PG8_MMA(0, 0, At, B0); PG8_BAR; PG8_SCHED;
            PG8_LDB(B1, 1, 1); PG8_STAGE(PG8_SB(1, 0), rB, b3, voffB);
            PG8_BAR; PG8_WAIT_L(0); PG8_MMA(0, 1, At, B1); PG8_BAR;
            PG8_LDA(At, 1, 1); PG8_STAGE(PG8_SA(1, 0), rA, a3, voffA);
            PG8_BAR; PG8_WAIT_L(0); PG8_MMA(1, 0, At, B0); PG8_BAR; PG8_SCHED;
            PG8_STAGE(PG8_SB(1, 1), rB, b3 + hstep, voffB);
            PG8_WAIT_V(6); PG8_BAR; PG8_MMA(1, 1, At, B1); PG8_BAR;
            }
        }
        if constexpr (ALIGN_EPI) { if (wr == 0) PG8_BAR; }
        { int fr_e = (int)(threadIdx.x & 15u), fq_e = (int)((threadIdx.x >> 4) & 3u);
          asm volatile("" : "+v"(fr_e), "+v"(fq_e));
          E(acc, cur, wr, wc, fr_e, fq_e); }
        if (!has_next) break;
#pragma unroll
        for (int a = 0; a < 2; ++a)
#pragma unroll
            for (int b = 0; b < 2; ++b)
#pragma unroll
                for (int m = 0; m < 4; ++m)
#pragma unroll
                    for (int n = 0; n < 2; ++n) acc[a][b][m][n] = (f32x4){0.f, 0.f, 0.f, 0.f};
        cur = nxt; cA = nA; cB = nB; ++ui;
        if constexpr (ALIGN_EPI) { if (wr == 1) PG8_BAR; }
    }
    PG8_WAIT_V(0);
    if constexpr (!ALIGN_EPI) { if (wr == 0) PG8_BAR; }
    PG8_BAR;
#undef PG8_SA
#undef PG8_SB
#undef PG8_STAGE
#undef PG8_LDA
#undef PG8_LDB
#undef PG8_MMA
#undef PG8_WAIT_V
#undef PG8_WAIT_L
#undef PG8_BAR
#undef PG8_SCHED
}
}

constexpr int CV_PREP = 11456, CV_S7 = 13696, CV_S5 = 18176, CV_S1 = 20992, CV_END = 23808;
struct TileDesc { const float* src; bf16_t* dst; const float* gk; int N, K; };
__device__ __forceinline__ TileDesc tile_make(const float* W, int K, int N, bf16_t* WT, int mode, int r, const float* gain) {
    const int nblk = N >> 6, kb = r / nblk, nb = r - kb * nblk, n0 = nb * 64, k0 = kb * 64;
    int drow0 = n0;
    if (mode) drow0 = 256 * (n0 >> 7) + (n0 & 127) + (mode == 2 ? 128 : 0);
    TileDesc d; d.src = W + (size_t)k0 * N + n0; d.dst = WT + (size_t)drow0 * K + k0; d.gk = gain ? gain + k0 : nullptr; d.N = N; d.K = K; return d;
}
__device__ __forceinline__ TileDesc tile_decode(const Params __attribute__((address_space(4)))* pp, unsigned char* ws, int it) {
    constexpr int TG = 2816;
    int r = it;
    if (r < 2560) return tile_make(pp->attn_w_in, 2048, 5120, (bf16_t*)(ws + O_WIN0), 0, r, nullptr); r -= 2560;
    if (r < 512) return tile_make(pp->attn_w_out, 1024, 2048, (bf16_t*)(ws + O_WOUT0), 0, r, nullptr); r -= 512;
    if (r < 1024) { const int l = r >> 9; return tile_make(pp->w_mem_kv + (size_t)l * 2048 * 1024, 2048, 1024, (bf16_t*)(ws + O_WKV) + (size_t)l * 1024 * 2048, 0, r & 511, nullptr); } r -= 1024;
    if (r < TG) return tile_make(pp->w_gate, 2048, 5632, (bf16_t*)(ws + O_WGU), 1, r, pp->ffn_norm); r -= TG;
    if (r < TG) return tile_make(pp->w_up, 2048, 5632, (bf16_t*)(ws + O_WGU), 2, r, pp->ffn_norm); r -= TG;
    if (r < TG) return tile_make(pp->w_up + (size_t)2048 * 5632, 2048, 5632, (bf16_t*)(ws + O_WGU) + (size_t)11264 * 2048, 2, r, pp->ffn_norm + DM); r -= TG;
    if (r < TG) return tile_make(pp->w_gate + (size_t)2048 * 5632, 2048, 5632, (bf16_t*)(ws + O_WGU) + (size_t)11264 * 2048, 1, r, pp->ffn_norm + DM); r -= TG;
    if (r < 1792) return tile_make(pp->sgu_w_in, 2048, 3584, (bf16_t*)(ws + O_WIN1), 0, r, pp->mix_norm + DM); r -= 1792;
    if (r < 1024) return tile_make(pp->sgu_w_out, 2048, 2048, (bf16_t*)(ws + O_WOUT1), 0, r, nullptr); r -= 1024;
    if (r < TG) return tile_make(pp->w_down, 5632, 2048, (bf16_t*)(ws + O_WDN), 0, r, nullptr); r -= TG;
    return tile_make(pp->w_down + (size_t)5632 * 2048, 5632, 2048, (bf16_t*)(ws + O_WDN) + (size_t)2048 * 5632, 0, r, nullptr);
}
__device__ __forceinline__ void tile_load(const TileDesc& d, f32x4 (&v)[16], int lane) {
    const float* p = d.src + (size_t)(lane >> 4) * d.N + 4 * (lane & 15);
#pragma unroll
    for (int i = 0; i < 16; ++i) v[i] = *(const f32x4*)(p + (size_t)(4 * i) * d.N);
}
__device__ __forceinline__ void tile_store(const TileDesc& d, const f32x4 (&v)[16], LAS float* scr, int lane) {
    const int r4 = lane >> 4, c4 = lane & 15;
#pragma unroll
    for (int i = 0; i < 16; ++i) {
        const float gg = d.gk ? d.gk[4 * i + r4] : 1.0f;
        LAS float* q = scr + (4 * i + r4) * 65 + 4 * c4;
        q[0] = v[i].x * gg; q[1] = v[i].y * gg; q[2] = v[i].z * gg; q[3] = v[i].w * gg;
    }
    LDS_WAIT();
    const int c = lane & 7;
#pragma unroll
    for (int j = 0; j < 8; ++j) {
        const int n = (lane >> 3) + 8 * j; const LAS float* s = scr + (8 * c) * 65 + n;
        u32x4 o; o.x = cvt_pk_bf16(s[0 * 65], s[1 * 65]); o.y = cvt_pk_bf16(s[2 * 65], s[3 * 65]); o.z = cvt_pk_bf16(s[4 * 65], s[5 * 65]); o.w = cvt_pk_bf16(s[6 * 65], s[7 * 65]);
        *(u32x4*)(d.dst + (size_t)n * d.K + 8 * c) = o;
    }
    LDS_WAIT();
}
__device__ __forceinline__ void convert_tiles(const Params __attribute__((address_space(4)))* pp, unsigned char* ws, int lo, int hi, int w0, int nw, LAS float* scr, int lane) {
    int it = lo + w0;
    if (it >= hi) return;
    TileDesc d0 = tile_decode(pp, ws, it);
    f32x4 v[16], vn[16];
    tile_load(d0, v, lane);
    for (;;) {
        const int it1 = it + nw; const bool has = it1 < hi;
        TileDesc d1 = d0;
        if (has) { d1 = tile_decode(pp, ws, it1); tile_load(d1, vn, lane); }
        tile_store(d0, v, scr, lane);
        if (!has) break;
#pragma unroll
        for (int i = 0; i < 16; ++i) v[i] = vn[i];
        d0 = d1; it = it1;
    }
}
__device__ __forceinline__ void rms_row(const float* xrow, const float* g, bf16_t* obf, float* of32, int lane) {
    const f32x4* xr = (const f32x4*)xrow + lane; const f32x4* gr = (const f32x4*)g + lane;
    f32x4 v[8]; float s = 0.f;
#pragma unroll
    for (int j = 0; j < 8; ++j) { v[j] = xr[64 * j]; s += (v[j].x * v[j].x + v[j].y * v[j].y) + (v[j].z * v[j].z + v[j].w * v[j].w); }
    const float rstd = rsqrtf(wave_sum(s) * (1.0f / 2048.0f) + 1e-6f);
    if (obf) {
        u32x2* o8 = (u32x2*)obf + lane;
#pragma unroll
        for (int j = 0; j < 8; ++j) { const f32x4 gg = gr[64 * j]; const f32x4 o = v[j] * rstd * gg; u32x2 w; w.x = cvt_pk_bf16(o.x, o.y); w.y = cvt_pk_bf16(o.z, o.w); o8[64 * j] = w; }
    } else {
        f32x4* o16 = (f32x4*)of32 + lane;
#pragma unroll
        for (int j = 0; j < 8; ++j) { const f32x4 gg = gr[64 * j]; o16[64 * j] = v[j] * rstd * gg; }
    }
}

constexpr int KS_PITCH = 272, VT_PITCH = 528, VT_OFF = 256 * KS_PITCH;
struct HalfRegs { u32x4 k[4]; u32x4 va[2], vb[2]; };
__device__ __forceinline__ void half_fetch(HalfRegs& h, const bf16_t* kp, const bf16_t* vp, unsigned kvs, int tid) {
    const int wid = tid >> 6, lane = tid & 63;
    { const int ch = tid & 15, r0 = tid >> 4;
#pragma unroll
      for (int i = 0; i < 4; ++i) h.k[i] = *(const u32x4*)(kp + (size_t)(r0 + 32 * i) * kvs + 8 * ch); }
    { const int cl = lane & 3, pair = (lane >> 2) + 16 * (wid & 3);
      const bf16_t* v0 = vp + (size_t)(2 * pair) * kvs;
#pragma unroll
      for (int i = 0; i < 2; ++i) { const int c = cl + 4 * ((wid >> 2) + 2 * i); h.va[i] = *(const u32x4*)(v0 + 8 * c); h.vb[i] = *(const u32x4*)(v0 + kvs + 8 * c); } }
}
__device__ __forceinline__ void half_commit(const HalfRegs& h, LAS unsigned char* lds, int slot, int tid) {
    const int wid = tid >> 6, lane = tid & 63;
    LAS unsigned char* Ks = lds + slot * (128 * KS_PITCH);
    LAS unsigned char* Vt = lds + VT_OFF + slot * 256;
    { const int ch = tid & 15, r0 = tid >> 4;
#pragma unroll
      for (int i = 0; i < 4; ++i) *(LAS u32x4*)(Ks + (r0 + 32 * i) * KS_PITCH + ch * 16) = h.k[i]; }
    { const int cl = lane & 3, pair = (lane >> 2) + 16 * (wid & 3);
#pragma unroll
      for (int i = 0; i < 2; ++i) { const int c = cl + 4 * ((wid >> 2) + 2 * i); const u32x4 a = h.va[i], b = h.vb[i];
          LAS unsigned char* dst = Vt + (8 * c) * VT_PITCH + 4 * pair;
          *(LAS unsigned*)(dst + 0 * VT_PITCH) = (a.x & 0xffffu) | (b.x << 16);
          *(LAS unsigned*)(dst + 1 * VT_PITCH) = (a.x >> 16) | (b.x & 0xffff0000u);
          *(LAS unsigned*)(dst + 2 * VT_PITCH) = (a.y & 0xffffu) | (b.y << 16);
          *(LAS unsigned*)(dst + 3 * VT_PITCH) = (a.y >> 16) | (b.y & 0xffff0000u);
          *(LAS unsigned*)(dst + 4 * VT_PITCH) = (a.z & 0xffffu) | (b.z << 16);
          *(LAS unsigned*)(dst + 5 * VT_PITCH) = (a.z >> 16) | (b.z & 0xffff0000u);
          *(LAS unsigned*)(dst + 6 * VT_PITCH) = (a.w & 0xffffu) | (b.w << 16);
          *(LAS unsigned*)(dst + 7 * VT_PITCH) = (a.w >> 16) | (b.w & 0xffff0000u); } }
}
__device__ __forceinline__ void q_fetch(bf16x8 (&qf)[4], const bf16_t* qp, unsigned qs, int tid) {
    const int wid = tid >> 6, lane = tid & 63, l15 = lane & 15, quad = lane >> 4;
    const bf16_t* qrow = qp + (size_t)(16 * wid + l15) * qs + 8 * quad;
#pragma unroll
    for (int ks = 0; ks < 4; ++ks) qf[ks] = *(const bf16x8*)(qrow + 32 * ks);
}
__device__ __forceinline__ void attn_compute(LAS unsigned char* lds, const bf16x8 (&qf)[4], int p, bf16_t* op, unsigned os, float* lp, unsigned ls, bool masked, bool first, int tid) {
    const int wid = __builtin_amdgcn_readfirstlane(tid >> 6), lane = tid & 63, l15 = lane & 15, quad = lane >> 4;
    LAS unsigned char* Ks = lds;
    LAS unsigned char* Vt = lds + VT_OFF;
    f32x4 s[16];
    const int qi = 16 * wid + l15;
#pragma unroll
    for (int kt = 0; kt < 16; ++kt) {
        f32x4 a = (f32x4){0.f, 0.f, 0.f, 0.f};
        if (!masked || (kt >= wid && kt <= wid + 8 && (!first || kt >= 8))) {
            const int pt = (kt + 8 * p) & 15;
#pragma unroll
            for (int ks = 0; ks < 4; ++ks) { const bf16x8 kf = *(const LAS bf16x8*)(Ks + (16 * pt + l15) * KS_PITCH + ks * 64 + quad * 16);
                a = __builtin_amdgcn_mfma_f32_16x16x32_bf16(kf, qf[ks], a, 0, 0, 0); }
        }
        s[kt] = a;
    }
    constexpr float SC = 0.08838834764831845f * 1.4426950408889634f;
    float mx = -3.0e38f;
#pragma unroll
    for (int kt = 0; kt < 16; ++kt) {
        if (!masked || (kt >= wid && kt <= wid + 8 && (!first || kt >= 8))) {
            if (masked && (kt == wid || kt == wid + 8)) {
#pragma unroll
                for (int j = 0; j < 4; ++j) { const int key = 16 * kt + 4 * quad + j; if (!(key >= qi && key <= qi + 128)) s[kt][j] = -1.0e30f; }
            }
            mx = fmaxf(mx, fmaxf(fmaxf(s[kt][0], s[kt][1]), fmaxf(s[kt][2], s[kt][3])));
        }
    }
    mx = fmaxf(mx, __shfl_xor(mx, 16)); mx = fmaxf(mx, __shfl_xor(mx, 32));
    const float nb = -mx * SC;
    float sum = 0.f;
#pragma unroll
    for (int kt = 0; kt < 16; ++kt) {
        if (!masked || (kt >= wid && kt <= wid + 8 && (!first || kt >= 8))) {
#pragma unroll
            for (int j = 0; j < 4; ++j) { const float pp_ = __builtin_amdgcn_exp2f(fmaf(s[kt][j], SC, nb)); s[kt][j] = pp_; sum += pp_; }
        }
    }
    sum += __shfl_xor(sum, 16); sum += __shfl_xor(sum, 32);
    bf16x8 pb[8];
#pragma unroll
    for (int t = 0; t < 8; ++t) { u32x4 w; w.x = cvt_pk_bf16(s[2 * t][0], s[2 * t][1]); w.y = cvt_pk_bf16(s[2 * t][2], s[2 * t][3]);
        w.z = cvt_pk_bf16(s[2 * t + 1][0], s[2 * t + 1][1]); w.w = cvt_pk_bf16(s[2 * t + 1][2], s[2 * t + 1][3]); pb[t] = __builtin_bit_cast(bf16x8, w); }
    const float inv = 1.0f / sum;
    bf16_t* orow = op + (size_t)qi * os + 4 * quad;
#pragma unroll
    for (int dt = 0; dt < 8; ++dt) {
        f32x4 a = (f32x4){0.f, 0.f, 0.f, 0.f};
#pragma unroll
        for (int t = 0; t < 8; ++t) {
            if (!masked || (2 * t + 1 >= wid && 2 * t <= wid + 8)) {
                const int pt = (t + 4 * p) & 7;
                const LAS unsigned char* vr = Vt + (16 * dt + l15) * VT_PITCH + (32 * pt + 4 * quad) * 2;
                const u32x2 lo = *(const LAS u32x2*)vr, hi = *(const LAS u32x2*)(vr + 32);
                u32x4 w; w.x = lo.x; w.y = lo.y; w.z = hi.x; w.w = hi.y;
                a = __builtin_amdgcn_mfma_f32_16x16x32_bf16(__builtin_bit_cast(bf16x8, w), pb[t], a, 0, 0, 0);
            }
        }
        u32x2 w; w.x = cvt_pk_bf16(a[0] * inv, a[1] * inv); w.y = cvt_pk_bf16(a[2] * inv, a[3] * inv);
        *(u32x2*)(orow + 16 * dt) = w;
    }
    if (lp && quad == 0) lp[(size_t)qi * ls] = (mx * SC + __log2f(sum)) * 0.6931471805599453f;
}
__device__ __forceinline__ void attn_run(LAS unsigned char* lds, int n0, int nit, const bf16_t* qp, unsigned qbs, unsigned qs, const bf16_t* kp, const bf16_t* vp, unsigned kbs, unsigned kvs,
                                         bf16_t* op, unsigned obs, unsigned os, float* lp, unsigned lbs, unsigned ls, bool masked, int tid) {
    HalfRegs hr; bf16x8 qf[4];
    __syncthreads();
    {
        HalfRegs h2;
        if (kbs == 0) {
            half_fetch(hr, kp, vp, kvs, tid); half_fetch(h2, kp + (size_t)128 * kvs, vp + (size_t)128 * kvs, kvs, tid);
            q_fetch(qf, qp + (size_t)n0 * qbs, qs, tid);
            half_commit(hr, lds, 0, tid); half_commit(h2, lds, 1, tid);
        } else {
            const int mprev = n0 > 0 ? n0 - 1 : 0;
            half_fetch(hr, kp + (size_t)mprev * kbs, vp + (size_t)mprev * kbs, kvs, tid); half_fetch(h2, kp + (size_t)n0 * kbs, vp + (size_t)n0 * kbs, kvs, tid);
            q_fetch(qf, qp + (size_t)n0 * qbs, qs, tid);
            half_commit(hr, lds, (n0 - 1) & 1, tid); half_commit(h2, lds, n0 & 1, tid);
        }
    }
    __syncthreads();
#pragma unroll 1
    for (int j = 0; j < nit; ++j) {
        const int n = n0 + j; const bool more = j + 1 < nit;
        if (more && kbs != 0) half_fetch(hr, kp + (size_t)(n + 1) * kbs, vp + (size_t)(n + 1) * kbs, kvs, tid);
        attn_compute(lds, qf, kbs == 0 ? 0 : ((n - 1) & 1), op + (size_t)n * obs, os, lp ? lp + (size_t)n * lbs : nullptr, ls, masked, masked && n == 0, tid);
        if (more) {
            __syncthreads();
            q_fetch(qf, qp + (size_t)(n + 1) * qbs, qs, tid);
            if (kbs != 0) half_commit(hr, lds, (n + 1) & 1, tid);
            __syncthreads();
        }
    }
}

__device__ __forceinline__ void sgu_item(LAS unsigned char* lds, const bf16_t* proj, const u64* stats, const float* lng, const float* lnb,
                                         const bf16_t* wsp, const float* bsp, bf16_t* cat, int n, int g, int tid) {
    const int wid = __builtin_amdgcn_readfirstlane(tid >> 6), lane = tid & 63, l15 = lane & 15, quad = lane >> 4;
    LAS unsigned char* Vt = lds + VT_OFF;
    __syncthreads();
    bf16x8 wf[4];
    { const bf16_t* wrow = wsp + (size_t)g * 16384 + (size_t)(16 * wid + l15) * 128 + 8 * quad;
#pragma unroll
      for (int ks = 0; ks < 4; ++ks) wf[ks] = *(const bf16x8*)(wrow + 32 * ks); }
    { const int cl = lane & 3, pair = (lane >> 2) + 16 * (wid & 3);
      const int row0 = 128 * n + 2 * pair;
      const f32x2 st0 = (f32x2){fs_get(stats + 2 * row0), fs_get(stats + 2 * row0 + 1)}, st1 = (f32x2){fs_get(stats + 2 * row0 + 2), fs_get(stats + 2 * row0 + 3)};
      const float mu0 = st0.x * (1.0f / 1536.0f), mu1 = st1.x * (1.0f / 1536.0f);
      const float rs0 = rsqrtf(fmaxf(st0.y * (1.0f / 1536.0f) - mu0 * mu0, 0.f) + 1e-5f), rs1 = rsqrtf(fmaxf(st1.y * (1.0f / 1536.0f) - mu1 * mu1, 0.f) + 1e-5f);
      const bf16_t* v0 = proj + (size_t)row0 * NIN1 + 1536 + 128 * g;
#pragma unroll
      for (int i = 0; i < 2; ++i) { const int c = cl + 4 * ((wid >> 2) + 2 * i);
          const u32x4 a = *(const u32x4*)(v0 + 8 * c), b = *(const u32x4*)(v0 + NIN1 + 8 * c);
          const f32x4 g0 = *(const f32x4*)(lng + 128 * g + 8 * c), g1 = *(const f32x4*)(lng + 128 * g + 8 * c + 4);
          const f32x4 b0 = *(const f32x4*)(lnb + 128 * g + 8 * c), b1 = *(const f32x4*)(lnb + 128 * g + 8 * c + 4);
          const unsigned aw[4] = {a.x, a.y, a.z, a.w}, bw[4] = {b.x, b.y, b.z, b.w};
          const float gg[8] = {g0.x, g0.y, g0.z, g0.w, g1.x, g1.y, g1.z, g1.w}, bb[8] = {b0.x, b0.y, b0.z, b0.w, b1.x, b1.y, b1.z, b1.w};
          LAS unsigned char* dst = Vt + (8 * c) * VT_PITCH + 4 * pair;
#pragma unroll
          for (int e = 0; e < 8; ++e) {
              const float xa = (e & 1) ? bf_hi(aw[e >> 1]) : bf_lo(aw[e >> 1]);
              const float xb = (e & 1) ? bf_hi(bw[e >> 1]) : bf_lo(bw[e >> 1]);
              const float ya = (xa - mu0) * rs0 * gg[e] + bb[e], yb = (xb - mu1) * rs1 * gg[e] + bb[e];
              *(LAS unsigned*)(dst + e * VT_PITCH) = cvt_pk_bf16(ya, yb);
          } } }
    __syncthreads();
    const int t = 16 * wid + l15;
    const float bias = bsp[g * 128 + t];
    const size_t grow = (size_t)(128 * n + t);
    const bf16_t* urow = proj + grow * NIN1 + 128 * g + 4 * quad;
    bf16_t* orow = cat + grow * 2048 + 128 * g + 4 * quad;
#pragma unroll
    for (int ct = 0; ct < 8; ++ct) {
        f32x4 a = (f32x4){0.f, 0.f, 0.f, 0.f};
#pragma unroll
        for (int ks = 0; ks < 4; ++ks) {
            if (32 * ks <= 16 * wid + 15) {
                const bf16x8 vf = *(const LAS bf16x8*)(Vt + (16 * ct + l15) * VT_PITCH + ks * 64 + quad * 16);
                a = __builtin_amdgcn_mfma_f32_16x16x32_bf16(vf, wf[ks], a, 0, 0, 0);
            }
        }
        const u32x2 uu = *(const u32x2*)(urow + 16 * ct);
        u32x2 w; w.x = cvt_pk_bf16((a[0] + bias) * bf_lo(uu.x), (a[1] + bias) * bf_hi(uu.x)); w.y = cvt_pk_bf16((a[2] + bias) * bf_lo(uu.y), (a[3] + bias) * bf_hi(uu.y));
        *(u32x2*)(orow + 16 * ct) = w;
    }
}

#define XB_TMO      128
#define XB_XCNT(j)  (256  + 64 * (j))
#define XB_XSUB(j)  (1280 + 64 * (j))
#define XB_XGEN(j)  (2304 + 64 * (j))
#define XB_TOP      3328
#define XB_TOPGEN   3392
#define XCD_BAR_WORDS 3456
#define XB_SPIN_CAP (1u << 18)
__device__ __forceinline__ unsigned xb_ld(unsigned* p)              { return __hip_atomic_load(p, __ATOMIC_RELAXED, __HIP_MEMORY_SCOPE_AGENT); }
__device__ __forceinline__ unsigned xb_add(unsigned* p, unsigned v) { return __hip_atomic_fetch_add(p, v, __ATOMIC_RELAXED, __HIP_MEMORY_SCOPE_AGENT); }
__device__ __forceinline__ unsigned xb_xcc_id() { return (unsigned)__builtin_amdgcn_s_getreg((3 << 11) | 20) & 0xFu; }
#define XB_SPIN(cond, bar) do { unsigned _sp = 0; while (cond) { __builtin_amdgcn_s_sleep(1); \
    if ((++_sp & 255u) == 0u) { if (xb_ld(&(bar)[XB_TMO])) break; if (_sp > XB_SPIN_CAP) { atomicAdd(&(bar)[XB_TMO], 1u); break; } } } } while (0)
struct XcdBarrier { unsigned* bar; unsigned x; volatile LAS unsigned* st; };
__device__ __forceinline__ XcdBarrier xcd_barrier_post(unsigned* bar, volatile LAS unsigned* st) {
    XcdBarrier b; b.bar = bar; b.x = xb_xcc_id(); b.st = st;
    if (threadIdx.x == 0) (void)xb_add(&bar[XB_XCNT(b.x)], 1u);
    return b;
}
__device__ __forceinline__ void xcd_barrier_complete(unsigned* bar, unsigned x, unsigned& nloc, unsigned& nx) {
    const unsigned G = gridDim.x * gridDim.y * gridDim.z;
    unsigned sum, cnt, mine, sp = 0u;
    for (;;) {
        sum = 0u; cnt = 0u; mine = 0u;
#pragma unroll
        for (unsigned j = 0; j < 16; ++j) { const unsigned c = xb_ld(&bar[XB_XCNT(j)]); sum += c; cnt += (c > 0u) ? 1u : 0u; mine = (j == x) ? c : mine; }
        if (sum == G) break;
        __builtin_amdgcn_s_sleep(1);
        if ((++sp & 255u) == 0u) { if (xb_ld(&bar[XB_TMO])) break; if (sp > XB_SPIN_CAP) { atomicAdd(&bar[XB_TMO], 1u); break; } }
    }
    nloc = mine > 0u ? mine : 1u; nx = cnt > 0u ? cnt : 1u;
}
__device__ __forceinline__ void xcd_barrier(const XcdBarrier& b) {
    asm volatile("s_waitcnt vmcnt(0)" ::: "memory");
    __syncthreads();
    if (threadIdx.x == 0) {
        unsigned* bar = b.bar;
        __builtin_amdgcn_s_waitcnt(0);
        unsigned nloc = b.st[0], nx = b.st[1];
        if (nloc == 0u) { xcd_barrier_complete(bar, b.x, nloc, nx); b.st[0] = nloc; b.st[1] = nx; }
        const unsigned old = xb_add(&bar[XB_XSUB(b.x)], 1u);
        const unsigned gen = old / nloc;
        if (old + 1u == (gen + 1u) * nloc) {
            __builtin_amdgcn_fence(__ATOMIC_RELEASE, "agent");
            asm volatile("s_waitcnt vmcnt(0)" ::: "memory");
            const unsigned og = xb_add(&bar[XB_TOP], 1u);
            const unsigned tg = og / nx;
            if (og + 1u == (tg + 1u) * nx) xb_add(&bar[XB_TOPGEN], 1u);
            else XB_SPIN(xb_ld(&bar[XB_TOPGEN]) == tg, bar);
            __builtin_amdgcn_fence(__ATOMIC_ACQUIRE, "agent");
            xb_add(&bar[XB_XGEN(b.x)], 1u);
            asm volatile("s_waitcnt vmcnt(0)" ::: "memory");
        } else {
            XB_SPIN(xb_ld(&bar[XB_XGEN(b.x)]) == gen, bar);
            __builtin_amdgcn_fence(__ATOMIC_ACQUIRE, "agent");
            asm volatile("s_waitcnt vmcnt(0)" ::: "memory");
        }
    }
    __syncthreads();
}

enum { K_PREP = 0, K_GEMM_BF = 1, K_MIX = 2, K_MERGE = 3, K_GEMM_RES = 4, K_NORM = 5, K_GEMM_GU = 6 };
constexpr unsigned long long KINDS = 0x0ull | (1ull << 4) | (2ull << 8) | (3ull << 12) | (4ull << 16) | (6ull << 20) | (4ull << 24) | (1ull << 28) | (2ull << 32) | (4ull << 36) |
                                     (6ull << 40) | (4ull << 44) | (5ull << 48);
constexpr int NSTEPS = 13;
#ifndef ENMASK
#define ENMASK 0x7f
#endif
#ifndef REP_MASK
#define REP_MASK 0
#endif
#ifndef SYNC_REP
#define SYNC_REP 1
#endif

__global__ void __launch_bounds__(512, 2) fwd_megakernel(Params p) {
    extern __shared__ __attribute__((aligned(16))) unsigned char lds_raw[];
    LAS unsigned char* lds = (LAS unsigned char*)lds_raw;
    cg::grid_group grid = cg::this_grid();
    const int G = gridDim.x, bid = blockIdx.x;
    if (threadIdx.x < 4) ((LAS unsigned*)(lds + LDS_CTL))[threadIdx.x] = 0u;
    __syncthreads();
    if (p.ws == nullptr) grid.sync();
    const XcdBarrier xbar = xcd_barrier_post((unsigned*)(p.ws + O_BAR), (volatile LAS unsigned*)(lds + LDS_CTL));
#pragma unroll 1
    for (int step = 0; step < NSTEPS; ++step) {
        const int kind = (int)((KINDS >> (4 * step)) & 15ull);
        const int layer = (step >= 7) ? 1 : 0;
        const bool idem = (kind == K_PREP) || (kind == K_MIX) || (kind == K_MERGE) || (kind == K_NORM) || (kind == K_GEMM_GU) || (kind == K_GEMM_BF && layer == 0);
        const int nrep = (REP_MASK != 0 && ((REP_MASK >> kind) & 1) && idem) ? 2 : 1;
#pragma unroll 1
        for (int rep = 0; rep < nrep; ++rep) {
        int tid = threadIdx.x; asm volatile("" : "+v"(tid));
        const Params __attribute__((address_space(4)))* pp = (const Params __attribute__((address_space(4)))*)__builtin_amdgcn_kernarg_segment_ptr();
        asm volatile("" : "+s"(pp));
        unsigned char* ws = pp->ws;
        const int lane = tid & 63, wave = __builtin_amdgcn_readfirstlane(tid >> 6);
        bf16_t* WIN0 = (bf16_t*)(ws + O_WIN0); bf16_t* WOUT0 = (bf16_t*)(ws + O_WOUT0); bf16_t* WIN1 = (bf16_t*)(ws + O_WIN1); bf16_t* WOUT1 = (bf16_t*)(ws + O_WOUT1);
        bf16_t* WGU = (bf16_t*)(ws + O_WGU); bf16_t* WDN = (bf16_t*)(ws + O_WDN); bf16_t* WKV = (bf16_t*)(ws + O_WKV); bf16_t* WSP = (bf16_t*)(ws + O_WSP);
        bf16_t* H = (bf16_t*)(ws + O_H); bf16_t* AO = (bf16_t*)(ws + O_H); bf16_t* BIG = (bf16_t*)(ws + O_BIG); bf16_t* CAT = (bf16_t*)(ws + O_CAT);
        float* LSE = (float*)(ws + O_LSE); bf16_t* MEMN = (bf16_t*)(ws + O_MEMN); bf16_t* MEMKV = (bf16_t*)(ws + O_MEMKV); float* ROPE = (float*)(ws + O_ROPE); u64* STATS = (u64*)(ws + O_STATS); u64* SS = (u64*)(ws + O_SS);

        int cv_lo = 0, cv_hi = 0, cv_w0 = 0, cv_nw = 1;
        switch (kind) {
        case K_PREP: if constexpr ((ENMASK >> 0) & 1) {
            const int gw = bid * 8 + wave, NGW = G * 8;
            cv_lo = 0; cv_hi = CV_PREP; cv_w0 = gw; cv_nw = NGW;
            for (int m = gw; m < SEQ + 512; m += NGW) {
                if (m < SEQ) rms_row(pp->x + (size_t)m * DM, pp->mix_norm, H + (size_t)m * DM, nullptr, lane);
                else { const int mm = m - SEQ, l = mm >> 8, r = mm & 255; rms_row(pp->mem + (size_t)r * DM, pp->mem_norm + l * DM, MEMN + (size_t)mm * DM, nullptr, lane); }
            }
            const int gt = bid * 512 + tid, NGT = G * 512;
            for (int i = gt; i < SEQ * 16; i += NGT) {
                const int t = i >> 4, f = i & 15;
                const float inv = exp2f(-(float)f * 1.1832230355827609f);
                const float ang = (float)pp->pos[t] * inv;
                const float k = rintf(ang * 0.15915494309189535f);
                float r = fmaf(-k, 6.28125f, ang); r = fmaf(-k, 0.0019353071795864769f, r);
                ROPE[2 * i] = __cosf(r); ROPE[2 * i + 1] = __sinf(r);
            }
            for (int i = gt; i < SEQ * 6; i += NGT) STATS[i] = 0u;
            for (int i = gt; i < 12 * 128 * 128; i += NGT) { const int tt = (i >> 7) & 127, ss = i & 127; const float w = (ss <= tt) ? pp->sgu_w_spatial[i] : 0.f; WSP[i] = (bf16_t)(cvt_pk_bf16(w, 0.f) & 0xffffu); }
        } break;
        case K_GEMM_BF: if constexpr ((ENMASK >> 1) & 1) {
            const int nsub = layer ? 1 : 2;
#pragma unroll 1
            for (int sub = 0; sub < nsub; ++sub) {
                pg8::Gemm g; pg8::Order S; pg8::EpiBf E;
                if (layer == 0 && sub == 0) { g = pg8::Gemm{H, WIN0, SEQ, NIN0, DM}; S.init(SEQ, NIN0, G, bid, 0); E = pg8::EpiBf{BIG, NIN0, 12, 0, 0, 0, ROPE, STATS, nullptr}; }
                else if (layer == 0) { g = pg8::Gemm{MEMN, WKV, 512, 2048, DM}; S.init(512, 2048, G, bid, 1); E = pg8::EpiBf{MEMKV, 2048, 0, 0, 0, 0, ROPE, STATS, nullptr}; }
                else { g = pg8::Gemm{H, WIN1, SEQ, NIN1, DM}; S.init(SEQ, NIN1, G, bid, 0); E = pg8::EpiBf{BIG, NIN1, 0, 12, 6, 12, ROPE, STATS, SS + SEQ}; }
                pg8::gemm_phase<pg8::EpiBf>(lds, g, S, E);
            }
            if (rep == 0) {
                if (layer == 0) { if (bid >= 136) { cv_lo = CV_S5; cv_hi = CV_S1; cv_w0 = (bid - 136) * 8 + wave; cv_nw = (G - 136) * 8; } }
                else { if (bid >= 192) { cv_lo = CV_PREP; cv_hi = CV_S7; cv_w0 = (bid - 192) * 8 + wave; cv_nw = (G - 192) * 8; } }
            }
        } break;
        case K_MIX: if constexpr ((ENMASK >> 2) & 1) {
            if (layer == 0) {
                if (bid < 192) {
                    const int g = bid >> 6, rr = bid & 63, h = rr & 3, chain = rr >> 2;
                    const int d = (g == 0) ? 1 : ((g == 1) ? 4 : 16), rpr = 16 / d, r = chain / rpr, n0 = 4 * (chain - r * rpr);
                    const bf16_t* base = BIG + (size_t)r * NIN0 + (4 * g + h) * 128;
                    attn_run(lds, n0, 4, base, 128u * d * NIN0, (unsigned)d * NIN0, base + 1536, base + 3072, 128u * d * NIN0, (unsigned)d * NIN0,
                             AO + (size_t)g * SEQ * 512 + (size_t)r * 512 + h * 128, 128u * d * 512, (unsigned)d * 512,
                             LSE + (size_t)g * SEQ * 4 + (size_t)r * 4 + h, 128u * d * 4, (unsigned)d * 4, true, tid);
                } else {
                    const int mb = bid - 192, h = mb & 3, n0 = 4 * (mb >> 2);
                    const bf16_t* kv = MEMKV + h * 128;
                    attn_run(lds, n0, 4, BIG + 4608 + h * 128, 128u * NIN0, (unsigned)NIN0, kv, kv + 512, 0u, 2048u,
                             CAT + 512 + h * 128, 128u * 1024, 1024u, nullptr, 0u, 0u, false, tid);
                }
            } else {
#pragma unroll 1
                for (int it = bid; it < 1024; it += G) {
                    if (it >= 768) {
                        const int rem = it - 768, h = rem & 3, n = rem >> 2;
                        const bf16_t* kv = MEMKV + (size_t)256 * 2048 + 1024 + h * 128;
                        attn_run(lds, n, 1, BIG + 3072 + h * 128, 128u * NIN1, (unsigned)NIN1, kv, kv + 512, 0u, 2048u,
                                 CAT + 1536 + h * 128, 128u * 2048, 2048u, nullptr, 0u, 0u, false, tid);
                    } else {
                        const int g = it % 12, n = it / 12;
                        sgu_item(lds, BIG, STATS, pp->sgu_ln_g, pp->sgu_ln_b, WSP, pp->sgu_b_spatial, CAT, n, g, tid);
                    }
                }
            }
        } break;
        case K_MERGE: if constexpr ((ENMASK >> 3) & 1) {
            const int gt = bid * 512 + tid, NGT = G * 512;
#pragma unroll 1
            for (int i0 = gt; i0 < SEQ * 64; i0 += 4 * NGT) {
                float l0[4], l1[4], l2[4]; u32x4 a[4], b[4], c[4];
#pragma unroll
                for (int j = 0; j < 4; ++j) {
                    const int i = (i0 + j * NGT < SEQ * 64) ? i0 + j * NGT : i0;
                    const int t = i >> 6, rem = i & 63, h = rem >> 4, c8 = rem & 15;
                    l0[j] = LSE[(size_t)t * 4 + h]; l1[j] = LSE[(size_t)SEQ * 4 + t * 4 + h]; l2[j] = LSE[(size_t)2 * SEQ * 4 + t * 4 + h];
                    const size_t off = (size_t)t * 512 + h * 128 + c8 * 8;
                    a[j] = *(const u32x4*)(AO + off); b[j] = *(const u32x4*)(AO + (size_t)SEQ * 512 + off); c[j] = *(const u32x4*)(AO + (size_t)2 * SEQ * 512 + off);
                }
#pragma unroll
                for (int j = 0; j < 4; ++j) {
                    const int i = i0 + j * NGT;
                    if (i < SEQ * 64) {
                        const int t = i >> 6, rem = i & 63, h = rem >> 4, c8 = rem & 15;
                        const float m = fmaxf(l0[j], fmaxf(l1[j], l2[j]));
                        float w0 = __expf(l0[j] - m), w1 = __expf(l1[j] - m), w2 = __expf(l2[j] - m);
                        const float inv = 1.0f / (w0 + w1 + w2); w0 *= inv; w1 *= inv; w2 *= inv;
                        const u32x4 aa = a[j], bb = b[j], cc = c[j];
                        u32x4 o;
                        o.x = cvt_pk_bf16(w0 * bf_lo(aa.x) + w1 * bf_lo(bb.x) + w2 * bf_lo(cc.x), w0 * bf_hi(aa.x) + w1 * bf_hi(bb.x) + w2 * bf_hi(cc.x));
                        o.y = cvt_pk_bf16(w0 * bf_lo(aa.y) + w1 * bf_lo(bb.y) + w2 * bf_lo(cc.y), w0 * bf_hi(aa.y) + w1 * bf_hi(bb.y) + w2 * bf_hi(cc.y));
                        o.z = cvt_pk_bf16(w0 * bf_lo(aa.z) + w1 * bf_lo(bb.z) + w2 * bf_lo(cc.z), w0 * bf_hi(aa.z) + w1 * bf_hi(bb.z) + w2 * bf_hi(cc.z));
                        o.w = cvt_pk_bf16(w0 * bf_lo(aa.w) + w1 * bf_lo(bb.w) + w2 * bf_lo(cc.w), w0 * bf_hi(aa.w) + w1 * bf_hi(bb.w) + w2 * bf_hi(cc.w));
                        *(u32x4*)(CAT + (size_t)t * 1024 + h * 128 + c8 * 8) = o;
                    }
                }
            }
        } break;
        case K_GEMM_RES: if constexpr ((ENMASK >> 4) & 1) {
            pg8::Gemm g; pg8::EpiRes E{nullptr, H, SS};
            if (step == 4) { g = pg8::Gemm{CAT, WOUT0, SEQ, DM, 1024}; E.base32 = pp->x; }
            else if (step == 6) { g = pg8::Gemm{BIG, WDN, SEQ, DM, FF}; E.ss = SS + SEQ; }
            else if (step == 9) { g = pg8::Gemm{CAT, WOUT1, SEQ, DM, 2048}; E.ss = SS + 2 * SEQ; }
            else { g = pg8::Gemm{BIG, WDN + (size_t)2048 * 5632, SEQ, DM, FF}; E.ss = SS + 3 * SEQ; }
            pg8::Order S; S.init(SEQ, DM, G, bid, 0);
            pg8::gemm_phase<pg8::EpiRes>(lds, g, S, E);
        } break;
        case K_NORM: if constexpr ((ENMASK >> 5) & 1) {
            const int gw = bid * 8 + wave, NGW = G * 8;
            for (int m = gw; m < SEQ; m += NGW) {
                const float rstd = rsqrtf(fx_get(SS + 3 * SEQ + m) * (1.0f / 2048.0f) + 1e-6f);
                const u32x4* xr = (const u32x4*)(H + (size_t)m * DM) + lane; const f32x4* gr = (const f32x4*)pp->final_norm + 2 * lane; f32x4* orow = (f32x4*)(pp->out + (size_t)m * DM) + 2 * lane;
#pragma unroll
                for (int j = 0; j < 4; ++j) { const u32x4 w = xr[64 * j]; const f32x4 g0 = gr[128 * j], g1 = gr[128 * j + 1];
                    orow[128 * j] = (f32x4){bf_lo(w.x), bf_hi(w.x), bf_lo(w.y), bf_hi(w.y)} * rstd * g0; orow[128 * j + 1] = (f32x4){bf_lo(w.z), bf_hi(w.z), bf_lo(w.w), bf_hi(w.w)} * rstd * g1; }
            }
        } break;
        case K_GEMM_GU: if constexpr ((ENMASK >> 6) & 1) {
            pg8::Gemm g{H, WGU + (size_t)layer * 11264 * 2048, SEQ, 11264, DM};
            pg8::Order S; S.init(SEQ, 11264, G, bid, 0);
            pg8::EpiGU E{BIG, SS + (layer ? 2 * SEQ : 0)};
            pg8::gemm_phase<pg8::EpiGU>(lds, g, S, E);
            if (rep == 0 && bid >= 128) {
                if (layer == 0) { cv_lo = CV_S7; cv_hi = CV_S5; } else { cv_lo = CV_S1; cv_hi = CV_END; }
                cv_w0 = (bid - 128) * 8 + wave; cv_nw = (G - 128) * 8;
            }
        } break;
        default: break;
        }
        if (cv_hi > cv_lo) convert_tiles(pp, ws, cv_lo, cv_hi, cv_w0, cv_nw, (LAS float*)(lds + wave * 16640), lane);
        if (step + 1 < NSTEPS || rep + 1 < nrep) {
#pragma unroll 1
            for (int sr = 0; sr < SYNC_REP; ++sr) xcd_barrier(xbar);
        }
        }
    }
}

extern "C" void kernel_launch(void* const* d_in, const int* in_sizes, int n_in, void* d_out, int out_size, void* d_ws, size_t ws_size, hipStream_t stream) {
    static int grid_blocks = 0;
    if (grid_blocks == 0) {
        if (n_in != 19 || ws_size < WS_NEED || out_size != SEQ * DM) { fprintf(stderr, "kernel_launch: unexpected problem (n_in %d, ws %zu need %zu, out %d)\n", n_in, ws_size, (size_t)WS_NEED, out_size); grid_blocks = -1; return; }
        int dev = 0, cus = 0, per_cu = 0;
        (void)hipGetDevice(&dev);
        (void)hipDeviceGetAttribute(&cus, hipDeviceAttributeMultiprocessorCount, dev);
        if (hipFuncSetAttribute((const void*)fwd_megakernel, hipFuncAttributeMaxDynamicSharedMemorySize, LDS_BYTES) != hipSuccess) { fprintf(stderr, "kernel_launch: hipFuncSetAttribute failed\n"); grid_blocks = -1; return; }
        if (hipOccupancyMaxActiveBlocksPerMultiprocessor(&per_cu, (const void*)fwd_megakernel, 512, LDS_BYTES) != hipSuccess || per_cu < 1) { fprintf(stderr, "kernel_launch: occupancy query failed (%d)\n", per_cu); grid_blocks = -1; return; }
        grid_blocks = cus * 1;
    }
    if (grid_blocks < 0) return;
    Params p{};
    p.x = (const float*)d_in[0]; p.mem = (const float*)d_in[1]; p.pos = (const int*)d_in[2];
    p.mix_norm = (const float*)d_in[3]; p.mem_norm = (const float*)d_in[4]; p.w_mem_kv = (const float*)d_in[5]; p.ffn_norm = (const float*)d_in[6];
    p.w_gate = (const float*)d_in[7]; p.w_up = (const float*)d_in[8]; p.w_down = (const float*)d_in[9];
    p.attn_w_in = (const float*)d_in[10]; p.attn_w_out = (const float*)d_in[11]; p.sgu_w_in = (const float*)d_in[12]; p.sgu_ln_g = (const float*)d_in[13]; p.sgu_ln_b = (const float*)d_in[14];
    p.sgu_w_spatial = (const float*)d_in[15]; p.sgu_b_spatial = (const float*)d_in[16]; p.sgu_w_out = (const float*)d_in[17]; p.final_norm = (const float*)d_in[18];
    p.out = (float*)d_out; p.ws = (unsigned char*)d_ws;
    if (hipMemsetAsync(d_ws, 0, BAR_BYTES, stream) != hipSuccess) { fprintf(stderr, "kernel_launch: memset failed\n"); return; }
    void* args[] = {&p};
    hipError_t e = hipLaunchCooperativeKernel((const void*)fwd_megakernel, dim3(grid_blocks), dim3(512), args, LDS_BYTES, stream);
    if (e != hipSuccess) fprintf(stderr, "kernel_launch: cooperative launch failed: %s (grid %d)\n", hipGetErrorString(e), grid_blocks);
}
```

```cpp
#include <hip/hip_runtime.h>
#include <hip/hip_cooperative_groups.h>
#include <cstdio>
#include <cstddef>
namespace cg = cooperative_groups;

#define LAS __attribute__((address_space(3)))
typedef unsigned short bf16_t;
typedef short bf16x8 __attribute__((ext_vector_type(8)));
typedef short bf16x4 __attribute__((ext_vector_type(4)));
typedef float f32x4 __attribute__((ext_vector_type(4)));
typedef float f32x2 __attribute__((ext_vector_type(2)));
typedef unsigned u32x4 __attribute__((ext_vector_type(4)));
typedef unsigned u32x2 __attribute__((ext_vector_type(2)));

constexpr int SEQ = 8192, DM = 2048, FF = 5632;
constexpr int NIN0 = 5120, NIN1 = 3584;
constexpr int LDS_CTL = 140288;
constexpr int LDS_BYTES = LDS_CTL + 16;

constexpr size_t O_BAR = 0;
constexpr size_t BAR_BYTES = 16384;
constexpr size_t O_WIN0 = O_BAR + BAR_BYTES;
constexpr size_t O_WOUT0 = O_WIN0 + (size_t)5120 * 2048 * 2;
constexpr size_t O_WIN1 = O_WOUT0 + (size_t)2048 * 1024 * 2;
constexpr size_t O_WOUT1 = O_WIN1 + (size_t)3584 * 2048 * 2;
constexpr size_t O_WGU = O_WOUT1 + (size_t)2048 * 2048 * 2;
constexpr size_t O_WDN = O_WGU + (size_t)2 * 11264 * 2048 * 2;
constexpr size_t O_WKV = O_WDN + (size_t)2 * 2048 * 5632 * 2;
constexpr size_t O_WSP = O_WKV + (size_t)2 * 1024 * 2048 * 2;
constexpr size_t O_H = O_WSP + (size_t)12 * 128 * 128 * 2;
constexpr size_t O_BIG = O_H + (size_t)8192 * 2048 * 2;
constexpr size_t O_CAT = O_BIG + (size_t)8192 * 5632 * 2;
constexpr size_t O_LSE = O_CAT + (size_t)8192 * 2048 * 2;
constexpr size_t O_MEMN = O_LSE + (size_t)3 * 8192 * 4 * 4;
constexpr size_t O_MEMKV = O_MEMN + (size_t)512 * 2048 * 2;
constexpr size_t O_ROPE = O_MEMKV + (size_t)512 * 2048 * 2;
constexpr size_t O_STATS = O_ROPE + (size_t)8192 * 16 * 2 * 4;
constexpr size_t O_SS = O_STATS + (size_t)8192 * 2 * 4;
constexpr size_t WS_NEED = O_SS + (size_t)4 * 8192 * 4;
static_assert(WS_NEED < 459000000ull, "workspace map too large");

struct Params {
    const float* x; const float* mem; const int* pos;
    const float* mix_norm; const float* mem_norm; const float* w_mem_kv; const float* ffn_norm;
    const float* w_gate; const float* w_up; const float* w_down;
    const float* attn_w_in; const float* attn_w_out; const float* sgu_w_in; const float* sgu_ln_g; const float* sgu_ln_b;
    const float* sgu_w_spatial; const float* sgu_b_spatial; const float* sgu_w_out; const float* final_norm;
    float* out; unsigned char* ws;
};

#define LDS_WAIT() asm volatile("s_waitcnt lgkmcnt(0)" ::: "memory")
__device__ __forceinline__ unsigned cvt_pk_bf16(float lo, float hi) { unsigned r; asm volatile("v_cvt_pk_bf16_f32 %0, %1, %2" : "=v"(r) : "v"(lo), "v"(hi)); return r; }
__device__ __forceinline__ float bf_lo(unsigned w) { return __uint_as_float(w << 16); }
__device__ __forceinline__ float bf_hi(unsigned w) { return __uint_as_float(w & 0xffff0000u); }
typedef unsigned u64;
__device__ __forceinline__ void fx_add(u64* p, float v) { atomicAdd(p, __float2uint_rn(v * 16384.0f)); }
__device__ __forceinline__ float fx_get(const u64* p) { return (float)(*p) * (1.0f / 16384.0f); }
__device__ __forceinline__ void fs_add(u64* p, float v) { atomicAdd((int*)p, __float2int_rn(v * 65536.0f)); }
__device__ __forceinline__ float fs_get(const u64* p) { return (float)(*(const int*)p) * (1.0f / 65536.0f); }
__device__ __forceinline__ float wave_sum(float v) {
#pragma unroll
    for (int o = 1; o < 64; o <<= 1) v += __shfl_xor(v, o);
    return v;
}
__device__ __forceinline__ float gelu_tanh(float x) {
    const float z2 = 1.5957691216057308f * (x + 0.044715f * x * x * x);
    return x * __builtin_amdgcn_rcpf(1.0f + __expf(-z2));
}
__device__ __forceinline__ float silu(float x) { return x * __builtin_amdgcn_rcpf(1.0f + __expf(-x)); }

namespace pg8 {
constexpr int BM = 256, BK = 64, HALF = 128, HTB = HALF * BK * 2, STAGE_BYTES = 8 * HTB, NXCD = 8, WGM = 4;
__device__ __forceinline__ int lds_byte(int r, int c) { const int st = (r >> 4) * 2 + (c >> 5), rr = r & 15, cc = c & 31, ob = rr * 64 + cc * 2; return st * 1024 + (ob ^ (((ob >> 9) & 1) << 5)); }
__device__ __forceinline__ void stage_rc(int b, int& R, int& C) { const int st = b / 1024, sb = b % 1024, swz = sb ^ (((sb >> 9) & 1) << 5); R = (st >> 1) * 16 + swz / 64; C = (st & 1) * 32 + (swz % 64) / 2; }
__device__ __forceinline__ int perm32(int rho) { const int n = rho >> 4, i = rho & 15; return 8 * (i >> 2) + 4 * n + (i & 3); }

struct Unit { int pm, pn; };
struct Gemm { const bf16_t* A; const bf16_t* Bt; int M, N, K; };
struct Order {
    int nM, nN, nwg, G, c, mode;
    __device__ void init(int M, int N, int G_, int c_, int mode_) { nM = M / BM; nN = N / BM; nwg = nM * nN; G = G_; c = c_; mode = mode_; }
    __device__ bool next(int i, Unit& u) const {
        if (mode == 1) { if (i != 0 || c < 128 || c >= 136) return false; u.pm = (c - 128) >> 2; u.pn = ((c - 128) & 3) + 4 * u.pm; return true; }
        const long L = (long)i * G + c; if (L >= nwg) return false;
        int wgid = (int)L; { const int q = nwg / NXCD, r = nwg % NXCD, xcd = wgid % NXCD, off = wgid / NXCD; wgid = (xcd < r ? xcd * (q + 1) : r * (q + 1) + (xcd - r) * q) + off; }
        const int nig = WGM * nN, gid = wgid / nig, fm = gid * WGM, gsz = (nM - fm) < WGM ? (nM - fm) : WGM;
        u.pm = fm + ((wgid % nig) % gsz); u.pn = (wgid % nig) / gsz; return true;
    }
};

struct EpiBf {
    static constexpr bool PERM = true;
    bf16_t* O; int ldc; int n_rot, n_gelu, st_lo, st_hi; const float* rope; u64* stats; const u64* ss;
    __device__ __forceinline__ void operator()(const f32x4 (&acc)[2][2][4][2], const Unit& u, int wr, int wc, int fr, int fq) const {
        const int row0 = u.pm * BM + wr * 64 + fr, col0 = u.pn * BM + wc * 32 + 8 * fq;
        const bool rot = (u.pn < n_rot) && (wc == 0), gel = u.pn < n_gelu, st = (u.pn >= st_lo) && (u.pn < st_hi);
        const float sgn = (fq < 2) ? -1.0f : 1.0f;
        float rstd[8];
#pragma unroll
        for (int i = 0; i < 8; ++i) rstd[i] = ss ? fx_get(ss + row0 + (i >> 2) * HALF + (i & 3) * 16) : 0.f;
#pragma unroll
        for (int i = 0; i < 8; ++i) rstd[i] = ss ? rsqrtf(rstd[i] * (1.0f / 2048.0f) + 1e-6f) : 1.0f;
#pragma unroll
        for (int ai = 0; ai < 2; ++ai)
#pragma unroll
            for (int m = 0; m < 4; ++m) {
                const int i = ai * 4 + m, row = row0 + ai * HALF + m * 16;
                f32x4 cs[4];
                if (rot) {
                    const f32x4* rp = (const f32x4*)(rope + (size_t)row * 32 + 16 * (fq & 1));
#pragma unroll
                    for (int q = 0; q < 4; ++q) cs[q] = rp[q];
                }
                float rs = 0.f, rq = 0.f;
#pragma unroll
                for (int bj = 0; bj < 2; ++bj) {
                    float v[8];
#pragma unroll
                    for (int j = 0; j < 4; ++j) { v[j] = acc[ai][bj][m][0][j] * rstd[i]; v[4 + j] = acc[ai][bj][m][1][j] * rstd[i]; }
                    if (rot) {
#pragma unroll
                        for (int e = 0; e < 8; ++e) {
                            const float p = __shfl_xor(v[e], 32);
                            const float c = cs[e >> 1][(e & 1) * 2], sn = cs[e >> 1][(e & 1) * 2 + 1];
                            v[e] = v[e] * c + sgn * p * sn;
                        }
                    }
                    if (gel) {
#pragma unroll
                        for (int e = 0; e < 8; ++e) v[e] = gelu_tanh(v[e]);
                    }
                    if (st) {
#pragma unroll
                        for (int e = 0; e < 8; ++e) { rs += v[e]; rq += v[e] * v[e]; }
                    }
                    u32x4 w; w.x = cvt_pk_bf16(v[0], v[1]); w.y = cvt_pk_bf16(v[2], v[3]); w.z = cvt_pk_bf16(v[4], v[5]); w.w = cvt_pk_bf16(v[6], v[7]);
                    *(u32x4*)(O + (size_t)row * ldc + col0 + bj * HALF) = w;
                }
                if (st) {
                    rs += __shfl_xor(rs, 16); rs += __shfl_xor(rs, 32);
                    rq += __shfl_xor(rq, 16); rq += __shfl_xor(rq, 32);
                    if (fq == 0) { fs_add(stats + 2 * row, rs); fs_add(stats + 2 * row + 1, rq); }
                }
            }
    }
};
struct EpiRes {
    static constexpr bool PERM = true;
    const float* base32; bf16_t* xb; u64* ss;
    __device__ __forceinline__ void load32(f32x4 (&b)[2][2], size_t off) const {
#pragma unroll
        for (int bj = 0; bj < 2; ++bj)
#pragma unroll
            for (int n = 0; n < 2; ++n) b[bj][n] = *(const f32x4*)(base32 + off + bj * HALF + n * 4);
    }
    __device__ __forceinline__ void operator()(const f32x4 (&acc)[2][2][4][2], const Unit& u, int wr, int wc, int fr, int fq) const {
        const int row0 = u.pm * BM + wr * 64 + fr, col0 = u.pn * BM + wc * 32 + 8 * fq;
        f32x4 b[2][2], bn[2][2];
        if (base32) load32(bn, (size_t)row0 * 2048 + col0);
#pragma unroll
        for (int ai = 0; ai < 2; ++ai) {
#pragma unroll
            for (int m = 0; m < 4; ++m) {
                const int row = row0 + ai * HALF + m * 16;
                const size_t off = (size_t)row * 2048 + col0;
                if (base32) {
#pragma unroll
                    for (int bj = 0; bj < 2; ++bj)
#pragma unroll
                        for (int n = 0; n < 2; ++n) b[bj][n] = bn[bj][n];
                    const int i1 = ai * 4 + m + 1;
                    if (i1 < 8) load32(bn, (size_t)(row0 + (i1 >> 2) * HALF + (i1 & 3) * 16) * 2048 + col0);
                } else {
#pragma unroll
                    for (int bj = 0; bj < 2; ++bj) { const u32x4 w = *(const u32x4*)(xb + off + bj * HALF);
                        b[bj][0] = (f32x4){bf_lo(w.x), bf_hi(w.x), bf_lo(w.y), bf_hi(w.y)}; b[bj][1] = (f32x4){bf_lo(w.z), bf_hi(w.z), bf_lo(w.w), bf_hi(w.w)}; }
                }
                float q = 0.f;
#pragma unroll
                for (int bj = 0; bj < 2; ++bj) {
                    const f32x4 v0 = b[bj][0] + acc[ai][bj][m][0], v1 = b[bj][1] + acc[ai][bj][m][1];
                    q += (v0.x * v0.x + v0.y * v0.y) + (v0.z * v0.z + v0.w * v0.w) + (v1.x * v1.x + v1.y * v1.y) + (v1.z * v1.z + v1.w * v1.w);
                    u32x4 w; w.x = cvt_pk_bf16(v0.x, v0.y); w.y = cvt_pk_bf16(v0.z, v0.w); w.z = cvt_pk_bf16(v1.x, v1.y); w.w = cvt_pk_bf16(v1.z, v1.w);
                    *(u32x4*)(xb + off + bj * HALF) = w;
                }
                if (ss) { q += __shfl_xor(q, 16); q += __shfl_xor(q, 32); if (fq == 0) fx_add(ss + row, q); }
            }
        }
    }
};
struct EpiGU {
    static constexpr bool PERM = true;
    bf16_t* O; const u64* ss;
    __device__ __forceinline__ void operator()(const f32x4 (&acc)[2][2][4][2], const Unit& u, int wr, int wc, int fr, int fq) const {
        const int row0 = u.pm * BM + wr * 64 + fr, col0 = u.pn * HALF + wc * 32 + 8 * fq;
        float rs8[8];
#pragma unroll
        for (int i = 0; i < 8; ++i) rs8[i] = fx_get(ss + row0 + (i >> 2) * HALF + (i & 3) * 16);
#pragma unroll
        for (int ai = 0; ai < 2; ++ai)
#pragma unroll
            for (int m = 0; m < 4; ++m) {
                const float rstd = rsqrtf(rs8[ai * 4 + m] * (1.0f / 2048.0f) + 1e-6f);
                float v[8];
#pragma unroll
                for (int n = 0; n < 2; ++n)
#pragma unroll
                    for (int j = 0; j < 4; ++j) v[4 * n + j] = silu(acc[ai][0][m][n][j] * rstd) * (acc[ai][1][m][n][j] * rstd);
                u32x4 w; w.x = cvt_pk_bf16(v[0], v[1]); w.y = cvt_pk_bf16(v[2], v[3]); w.z = cvt_pk_bf16(v[4], v[5]); w.w = cvt_pk_bf16(v[6], v[7]);
                *(u32x4*)(O + (size_t)(row0 + ai * HALF + m * 16) * FF + col0) = w;
            }
    }
};

template <class Epi, bool ALIGN_EPI = true, bool SP2 = true>
__device__ __forceinline__ void gemm_phase(LAS unsigned char* lds, const Gemm g, const Order& S, const Epi& E) {
    const int tid = threadIdx.x, wid = __builtin_amdgcn_readfirstlane(tid >> 6), lane = tid & 63, wr = wid >> 2, wc = wid & 3, fr = lane & 15, fq = lane >> 4;
    const int K = g.K, nt = K / BK;
    unsigned voffA[2], voffB[2];
#pragma unroll
    for (int i = 0; i < 2; ++i) { int R, C; stage_rc(tid * 16 + i * 8192, R, C); const int Rb = Epi::PERM ? ((R & ~31) + perm32(R & 31)) : R;
        voffA[i] = (unsigned)(R * K + C) * 2u; voffB[i] = (unsigned)(Rb * K + C) * 2u; }
    const unsigned kstep = (unsigned)(BK * 2);
    const unsigned hstep = (unsigned)HALF * (unsigned)K * 2u;
    const unsigned tstep = 2u * hstep;
    const __amdgpu_buffer_rsrc_t rA = __builtin_amdgcn_make_buffer_rsrc((void*)g.A, (short)0, (int)((unsigned)g.M * (unsigned)K * 2u), 0x00020000);
    const __amdgpu_buffer_rsrc_t rB = __builtin_amdgcn_make_buffer_rsrc((void*)g.Bt, (short)0, (int)((unsigned)g.N * (unsigned)K * 2u), 0x00020000);
    const unsigned ldsw = (unsigned)wid * 1024u;
    const int aoff = lds_byte(wr * 64 + fr, fq * 8), boff = lds_byte(wc * 32 + fr, fq * 8);
#define PG8_SA(b, h) (((b) * 2 + (h)) * HTB)
#define PG8_SB(b, h) ((4 + (b) * 2 + (h)) * HTB)
#define PG8_STAGE(bufoff, rsrc, soff, voff) do { _Pragma("unroll") for (int _i = 0; _i < 2; ++_i) \
        __builtin_amdgcn_raw_ptr_buffer_load_lds((rsrc), (LAS unsigned*)(lds + (bufoff) + ldsw + _i * 8192), 16, (int)(voff)[_i], (int)(soff), 0, 0); } while (0)
#define PG8_LDA(dst, b, h) do { _Pragma("unroll") for (int m = 0; m < 4; ++m) _Pragma("unroll") for (int k = 0; k < 2; ++k) dst[m][k] = *(const LAS bf16x8*)(lds + PG8_SA(b, h) + aoff + m * 2048 + k * 1024); } while (0)
#define PG8_LDB(dst, b, h) do { _Pragma("unroll") for (int n = 0; n < 2; ++n) _Pragma("unroll") for (int k = 0; k < 2; ++k) dst[n][k] = *(const LAS bf16x8*)(lds + PG8_SB(b, h) + boff + n * 2048 + k * 1024); } while (0)
#define PG8_MMA(ai, bj, At, Bt) do { __builtin_amdgcn_s_setprio(1); _Pragma("unroll") for (int m = 0; m < 4; ++m) _Pragma("unroll") for (int n = 0; n < 2; ++n) _Pragma("unroll") for (int k = 0; k < 2; ++k) \
        acc[ai][bj][m][n] = __builtin_amdgcn_mfma_f32_16x16x32_bf16(Bt[n][k], At[m][k], acc[ai][bj][m][n], 0, 0, 0); __builtin_amdgcn_s_setprio(0); } while (0)
#define PG8_WAIT_V(n) asm volatile("s_waitcnt vmcnt(" #n ")" ::: "memory")
#define PG8_WAIT_L(n) asm volatile("s_waitcnt lgkmcnt(" #n ")" ::: "memory")
#define PG8_BAR __builtin_amdgcn_s_barrier()
#define PG8_SCHED __builtin_amdgcn_sched_barrier(0)
    Unit cur, nxt; int ui = 0;
    if (!S.next(0, cur)) return;
    f32x4 acc[2][2][4][2];
#pragma unroll
    for (int a = 0; a < 2; ++a)
#pragma unroll
        for (int b = 0; b < 2; ++b)
#pragma unroll
            for (int m = 0; m < 4; ++m)
#pragma unroll
                for (int n = 0; n < 2; ++n) acc[a][b][m][n] = (f32x4){0.f, 0.f, 0.f, 0.f};
    bf16x8 At[4][2], B0[2][2], B1[2][2];
    unsigned cA = (unsigned)cur.pm * tstep, cB = (unsigned)cur.pn * tstep;
    if constexpr (SP2) {
        PG8_STAGE(PG8_SB(0, 0), rB, cB, voffB); PG8_STAGE(PG8_SB(0, 1), rB, cB + hstep, voffB); PG8_STAGE(PG8_SA(0, 0), rA, cA, voffA); PG8_STAGE(PG8_SA(0, 1), rA, cA + hstep, voffA);
        if (wr == 1) PG8_BAR;
        PG8_WAIT_V(2); PG8_BAR;
        PG8_STAGE(PG8_SB(1, 0), rB, cB + kstep, voffB); PG8_STAGE(PG8_SA(1, 0), rA, cA + kstep, voffA); PG8_STAGE(PG8_SB(1, 1), rB, cB + hstep + kstep, voffB);
        PG8_WAIT_V(6); PG8_BAR;
    } else {
        PG8_STAGE(PG8_SB(0, 0), rB, cB, voffB); PG8_STAGE(PG8_SA(0, 0), rA, cA, voffA); PG8_STAGE(PG8_SB(0, 1), rB, cB + hstep, voffB); PG8_STAGE(PG8_SA(0, 1), rA, cA + hstep, voffA);
        if (wr == 1) PG8_BAR;
        PG8_WAIT_V(4); PG8_BAR;
        PG8_STAGE(PG8_SB(1, 0), rB, cB + kstep, voffB); PG8_STAGE(PG8_SA(1, 0), rA, cA + kstep, voffA); PG8_STAGE(PG8_SB(1, 1), rB, cB + hstep + kstep, voffB);
        PG8_WAIT_V(6); PG8_BAR;
    }
    for (;;) {
        const bool has_next = S.next(ui + 1, nxt);
        const unsigned nA = has_next ? (unsigned)nxt.pm * tstep : cA, nB = has_next ? (unsigned)nxt.pn * tstep : cB;
        for (int t = 0; t < nt; t += 2) {
            const bool last = (t == nt - 2);
            const unsigned a1 = cA + (unsigned)(t + 1) * kstep;
            const unsigned a2 = last ? nA : cA + (unsigned)(t + 2) * kstep, b2 = last ? nB : cB + (unsigned)(t + 2) * kstep;
            const unsigned a3 = a2 + kstep, b3 = b2 + kstep;
            if constexpr (SP2) {
            PG8_LDB(B0, 0, 0); PG8_LDB(B1, 0, 1); PG8_SCHED; PG8_LDA(At, 0, 0); PG8_STAGE(PG8_SA(1, 1), rA, a1 + hstep, voffA);
            PG8_WAIT_V(8); PG8_WAIT_L(0); PG8_BAR; PG8_MMA(0, 0, At, B0); PG8_MMA(0, 1, At, B1); PG8_BAR; PG8_SCHED;
            PG8_LDA(At, 0, 1); PG8_STAGE(PG8_SB(0, 0), rB, b2, voffB); PG8_STAGE(PG8_SB(0, 1), rB, b2 + hstep, voffB); PG8_STAGE(PG8_SA(0, 0), rA, a2, voffA);
            PG8_WAIT_V(8); PG8_WAIT_L(0); PG8_BAR; PG8_MMA(1, 0, At, B0); PG8_MMA(1, 1, At, B1); PG8_BAR; PG8_SCHED;
            PG8_LDB(B0, 1, 0); PG8_LDB(B1, 1, 1); PG8_SCHED; PG8_LDA(At, 1, 0); PG8_STAGE(PG8_SA(0, 1), rA, a2 + hstep, voffA);
            PG8_WAIT_V(8); PG8_WAIT_L(0); PG8_BAR; PG8_MMA(0, 0, At, B0); PG8_MMA(0, 1, At, B1); PG8_BAR; PG8_SCHED;
            PG8_LDA(At, 1, 1); PG8_STAGE(PG8_SB(1, 0), rB, b3, voffB); PG8_STAGE(PG8_SB(1, 1), rB, b3 + hstep, voffB); PG8_STAGE(PG8_SA(1, 0), rA, a3, voffA);
            PG8_WAIT_V(8); PG8_WAIT_L(0); PG8_BAR; PG8_MMA(1, 0, At, B0); PG8_MMA(1, 1, At, B1); PG8_BAR; PG8_SCHED;
            } else {
            PG8_LDB(B0, 0, 0); PG8_SCHED; PG8_LDA(At, 0, 0); PG8_STAGE(PG8_SA(1, 1), rA, a1 + hstep, voffA);
            PG8_WAIT_L(8); PG8_BAR; PG8_WAIT_L(0); PG8_MMA(0, 0, At, B0); PG8_BAR; PG8_SCHED;
            PG8_LDB(B1, 0, 1); PG8_STAGE(PG8_SB(0, 0), rB, b2, voffB);
            PG8_BAR; PG8_WAIT_L(0); PG8_MMA(0, 1, At, B1); PG8_BAR;
            PG8_LDA(At, 0, 1); PG8_STAGE(PG8_SA(0, 0), rA, a2, voffA);
            PG8_BAR; PG8_WAIT_L(0); PG8_MMA(1, 0, At, B0); PG8_BAR; PG8_SCHED;
            PG8_STAGE(PG8_SB(0, 1), rB, b2 + hstep, voffB);
            PG8_WAIT_V(6); PG8_BAR; PG8_MMA(1, 1, At, B1); PG8_BAR;
            PG8_LDB(B0, 1, 0); PG8_SCHED; PG8_LDA(At, 1, 0); PG8_STAGE(PG8_SA(0, 1), rA, a2 + hstep, voffA);
            PG8_WAIT_L(8); PG8_BAR; PG8_WAIT_L(0); PG8_MMA(0, 0, At, B0); PG8_BAR; PG8_SCHED;
            PG8_LDB(B1, 1, 1); PG8_STAGE(PG8_SB(1, 0), rB, b3, voffB);
            PG8_BAR; PG8_WAIT_L(0); PG8_MMA(0, 1, At, B1); PG8_BAR;
            PG8_LDA(At, 1, 1); PG8_STAGE(PG8_SA(1, 0), rA, a3, voffA);
            PG8_BAR; PG8_WAIT_L(0); PG8_MMA(1, 0, At, B0); PG8_BAR; PG8_SCHED;
            PG8_STAGE(PG8_SB(1, 1), rB, b3 + hstep, voffB);
            PG8_WAIT_V(6); PG8_BAR; PG8_MMA(1, 1, At, B1); PG8_BAR;
            }
        }
        if constexpr (ALIGN_EPI) { if (wr == 0) PG8_BAR; }
        { int fr_e = (int)(threadIdx.x & 15u), fq_e = (int)((threadIdx.x >> 4) & 3u);
          asm volatile("" : "+v"(fr_e), "+v"(fq_e));
          E(acc, cur, wr, wc, fr_e, fq_e); }
        if (!has_next) break;
#pragma unroll
        for (int a = 0; a < 2; ++a)
#pragma unroll
            for (int b = 0; b < 2; ++b)
#pragma unroll
                for (int m = 0; m < 4; ++m)
#pragma unroll
                    for (int n = 0; n < 2; ++n) acc[a][b][m][n] = (f32x4){0.f, 0.f, 0.f, 0.f};
        cur = nxt; cA = nA; cB = nB; ++ui;
        if constexpr (ALIGN_EPI) { if (wr == 1) PG8_BAR; }
    }
    PG8_WAIT_V(0);
    if constexpr (!ALIGN_EPI) { if (wr == 0) PG8_BAR; }
    PG8_BAR;
#undef PG8_SA
#undef PG8_SB
#undef PG8_STAGE
#undef PG8_LDA
#undef PG8_LDB
#undef PG8_MMA
#undef PG8_WAIT_V
#undef PG8_WAIT_L
#undef PG8_BAR
#undef PG8_SCHED
}
}

constexpr int CV_PREP = 11456, CV_S7 = 13696, CV_S5 = 18176, CV_S1 = 20992, CV_END = 23808;
struct TileDesc { const float* src; bf16_t* dst; const float* gk; int N, K; };
__device__ __forceinline__ TileDesc tile_make(const float* W, int K, int N, bf16_t* WT, int mode, int r, const float* gain) {
    const int nblk = N >> 6, kb = r / nblk, nb = r - kb * nblk, n0 = nb * 64, k0 = kb * 64;
    int drow0 = n0;
    if (mode) drow0 = 256 * (n0 >> 7) + (n0 & 127) + (mode == 2 ? 128 : 0);
    TileDesc d; d.src = W + (size_t)k0 * N + n0; d.dst = WT + (size_t)drow0 * K + k0; d.gk = gain ? gain + k0 : nullptr; d.N = N; d.K = K; return d;
}
__device__ __forceinline__ TileDesc tile_decode(const Params __attribute__((address_space(4)))* pp, unsigned char* ws, int it) {
    constexpr int TG = 2816;
    int r = it;
    if (r < 2560) return tile_make(pp->attn_w_in, 2048, 5120, (bf16_t*)(ws + O_WIN0), 0, r, nullptr); r -= 2560;
    if (r < 512) return tile_make(pp->attn_w_out, 1024, 2048, (bf16_t*)(ws + O_WOUT0), 0, r, nullptr); r -= 512;
    if (r < 1024) { const int l = r >> 9; return tile_make(pp->w_mem_kv + (size_t)l * 2048 * 1024, 2048, 1024, (bf16_t*)(ws + O_WKV) + (size_t)l * 1024 * 2048, 0, r & 511, nullptr); } r -= 1024;
    if (r < TG) return tile_make(pp->w_gate, 2048, 5632, (bf16_t*)(ws + O_WGU), 1, r, pp->ffn_norm); r -= TG;
    if (r < TG) return tile_make(pp->w_up, 2048, 5632, (bf16_t*)(ws + O_WGU), 2, r, pp->ffn_norm); r -= TG;
    if (r < TG) return tile_make(pp->w_up + (size_t)2048 * 5632, 2048, 5632, (bf16_t*)(ws + O_WGU) + (size_t)11264 * 2048, 2, r, pp->ffn_norm + DM); r -= TG;
    if (r < TG) return tile_make(pp->w_gate + (size_t)2048 * 5632, 2048, 5632, (bf16_t*)(ws + O_WGU) + (size_t)11264 * 2048, 1, r, pp->ffn_norm + DM); r -= TG;
    if (r < 1792) return tile_make(pp->sgu_w_in, 2048, 3584, (bf16_t*)(ws + O_WIN1), 0, r, pp->mix_norm + DM); r -= 1792;
    if (r < 1024) return tile_make(pp->sgu_w_out, 2048, 2048, (bf16_t*)(ws + O_WOUT1), 0, r, nullptr); r -= 1024;
    if (r < TG) return tile_make(pp->w_down, 5632, 2048, (bf16_t*)(ws + O_WDN), 0, r, nullptr); r -= TG;
    return tile_make(pp->w_down + (size_t)5632 * 2048, 5632, 2048, (bf16_t*)(ws + O_WDN) + (size_t)2048 * 5632, 0, r, nullptr);
}
__device__ __forceinline__ void tile_load(const TileDesc& d, f32x4 (&v)[16], int lane) {
    const float* p = d.src + (size_t)(lane >> 4) * d.N + 4 * (lane & 15);
#pragma unroll
    for (int i = 0; i < 16; ++i) v[i] = __builtin_nontemporal_load((const f32x4*)(p + (size_t)(4 * i) * d.N));
}
__device__ __forceinline__ void tile_store(const TileDesc& d, const f32x4 (&v)[16], LAS float* scr, int lane) {
    const int r4 = lane >> 4, c4 = lane & 15;
#pragma unroll
    for (int i = 0; i < 16; ++i) {
        const float gg = d.gk ? d.gk[4 * i + r4] : 1.0f;
        LAS float* q = scr + (4 * i + r4) * 65 + 4 * c4;
        q[0] = v[i].x * gg; q[1] = v[i].y * gg; q[2] = v[i].z * gg; q[3] = v[i].w * gg;
    }
    LDS_WAIT();
    const int c = lane & 7;
#pragma unroll
    for (int j = 0; j < 8; ++j) {
        const int n = (lane >> 3) + 8 * j; const LAS float* s = scr + (8 * c) * 65 + n;
        u32x4 o; o.x = cvt_pk_bf16(s[0 * 65], s[1 * 65]); o.y = cvt_pk_bf16(s[2 * 65], s[3 * 65]); o.z = cvt_pk_bf16(s[4 * 65], s[5 * 65]); o.w = cvt_pk_bf16(s[6 * 65], s[7 * 65]);
        *(u32x4*)(d.dst + (size_t)n * d.K + 8 * c) = o;
    }
    LDS_WAIT();
}
__device__ __forceinline__ void convert_tiles(const Params __attribute__((address_space(4)))* pp, unsigned char* ws, int lo, int hi, int w0, int nw, LAS float* scr, int lane) {
    int it = lo + w0;
    if (it >= hi) return;
    TileDesc d0 = tile_decode(pp, ws, it);
    f32x4 v[16], vn[16];
    tile_load(d0, v, lane);
    for (;;) {
        const int it1 = it + nw; const bool has = it1 < hi;
        TileDesc d1 = d0;
        if (has) { d1 = tile_decode(pp, ws, it1); tile_load(d1, vn, lane); }
        tile_store(d0, v, scr, lane);
        if (!has) break;
#pragma unroll
        for (int i = 0; i < 16; ++i) v[i] = vn[i];
        d0 = d1; it = it1;
    }
}
__device__ __forceinline__ void rms_row(const float* xrow, const float* g, bf16_t* obf, float* of32, int lane) {
    const f32x4* xr = (const f32x4*)xrow + lane; const f32x4* gr = (const f32x4*)g + lane;
    f32x4 v[8]; float s = 0.f;
#pragma unroll
    for (int j = 0; j < 8; ++j) { v[j] = xr[64 * j]; s += (v[j].x * v[j].x + v[j].y * v[j].y) + (v[j].z * v[j].z + v[j].w * v[j].w); }
    const float rstd = rsqrtf(wave_sum(s) * (1.0f / 2048.0f) + 1e-6f);
    if (obf) {
        u32x2* o8 = (u32x2*)obf + lane;
#pragma unroll
        for (int j = 0; j < 8; ++j) { const f32x4 gg = gr[64 * j]; const f32x4 o = v[j] * rstd * gg; u32x2 w; w.x = cvt_pk_bf16(o.x, o.y); w.y = cvt_pk_bf16(o.z, o.w); o8[64 * j] = w; }
    } else {
        f32x4* o16 = (f32x4*)of32 + lane;
#pragma unroll
        for (int j = 0; j < 8; ++j) { const f32x4 gg = gr[64 * j]; o16[64 * j] = v[j] * rstd * gg; }
    }
}

constexpr int KS_PITCH = 272, VT_PITCH = 528, VT_OFF = 256 * KS_PITCH;
struct HalfRegs { u32x4 k[4]; u32x4 va[2], vb[2]; };
__device__ __forceinline__ void half_fetch(HalfRegs& h, const bf16_t* kp, const bf16_t* vp, unsigned kvs, int tid) {
    const int wid = tid >> 6, lane = tid & 63;
    { const int ch = tid & 15, r0 = tid >> 4;
#pragma unroll
      for (int i = 0; i < 4; ++i) h.k[i] = *(const u32x4*)(kp + (size_t)(r0 + 32 * i) * kvs + 8 * ch); }
    { const int cl = lane & 3, pair = (lane >> 2) + 16 * (wid & 3);
      const bf16_t* v0 = vp + (size_t)(2 * pair) * kvs;
#pragma unroll
      for (int i = 0; i < 2; ++i) { const int c = cl + 4 * ((wid >> 2) + 2 * i); h.va[i] = *(const u32x4*)(v0 + 8 * c); h.vb[i] = *(const u32x4*)(v0 + kvs + 8 * c); } }
}
__device__ __forceinline__ void half_commit(const HalfRegs& h, LAS unsigned char* lds, int slot, int tid) {
    const int wid = tid >> 6, lane = tid & 63;
    LAS unsigned char* Ks = lds + slot * (128 * KS_PITCH);
    LAS unsigned char* Vt = lds + VT_OFF + slot * 256;
    { const int ch = tid & 15, r0 = tid >> 4;
#pragma unroll
      for (int i = 0; i < 4; ++i) *(LAS u32x4*)(Ks + (r0 + 32 * i) * KS_PITCH + ch * 16) = h.k[i]; }
    { const int cl = lane & 3, pair = (lane >> 2) + 16 * (wid & 3);
#pragma unroll
      for (int i = 0; i < 2; ++i) { const int c = cl + 4 * ((wid >> 2) + 2 * i); const u32x4 a = h.va[i], b = h.vb[i];
          LAS unsigned char* dst = Vt + (8 * c) * VT_PITCH + 4 * pair;
          *(LAS unsigned*)(dst + 0 * VT_PITCH) = (a.x & 0xffffu) | (b.x << 16);
          *(LAS unsigned*)(dst + 1 * VT_PITCH) = (a.x >> 16) | (b.x & 0xffff0000u);
          *(LAS unsigned*)(dst + 2 * VT_PITCH) = (a.y & 0xffffu) | (b.y << 16);
          *(LAS unsigned*)(dst + 3 * VT_PITCH) = (a.y >> 16) | (b.y & 0xffff0000u);
          *(LAS unsigned*)(dst + 4 * VT_PITCH) = (a.z & 0xffffu) | (b.z << 16);
          *(LAS unsigned*)(dst + 5 * VT_PITCH) = (a.z >> 16) | (b.z & 0xffff0000u);
          *(LAS unsigned*)(dst + 6 * VT_PITCH) = (a.w & 0xffffu) | (b.w << 16);
          *(LAS unsigned*)(dst + 7 * VT_PITCH) = (a.w >> 16) | (b.w & 0xffff0000u); } }
}
__device__ __forceinline__ void q_fetch(bf16x8 (&qf)[4], const bf16_t* qp, unsigned qs, int tid) {
    const int wid = tid >> 6, lane = tid & 63, l15 = lane & 15, quad = lane >> 4;
    const bf16_t* qrow = qp + (size_t)(16 * wid + l15) * qs + 8 * quad;
#pragma unroll
    for (int ks = 0; ks < 4; ++ks) qf[ks] = *(const bf16x8*)(qrow + 32 * ks);
}
__device__ __forceinline__ void attn_compute(LAS unsigned char* lds, const bf16x8 (&qf)[4], int p, bf16_t* op, unsigned os, float* lp, unsigned ls, bool masked, bool first, int tid) {
    const int wid = __builtin_amdgcn_readfirstlane(tid >> 6), lane = tid & 63, l15 = lane & 15, quad = lane >> 4;
    LAS unsigned char* Ks = lds;
    LAS unsigned char* Vt = lds + VT_OFF;
    f32x4 s[16];
    const int qi = 16 * wid + l15;
#pragma unroll
    for (int kt = 0; kt < 16; ++kt) {
        f32x4 a = (f32x4){0.f, 0.f, 0.f, 0.f};
        if (!masked || (kt >= wid && kt <= wid + 8 && (!first || kt >= 8))) {
            const int pt = (kt + 8 * p) & 15;
#pragma unroll
            for (int ks = 0; ks < 4; ++ks) { const bf16x8 kf = *(const LAS bf16x8*)(Ks + (16 * pt + l15) * KS_PITCH + ks * 64 + quad * 16);
                a = __builtin_amdgcn_mfma_f32_16x16x32_bf16(kf, qf[ks], a, 0, 0, 0); }
        }
        s[kt] = a;
    }
    constexpr float SC = 0.08838834764831845f * 1.4426950408889634f;
    float mx = -3.0e38f;
#pragma unroll
    for (int kt = 0; kt < 16; ++kt) {
        if (!masked || (kt >= wid && kt <= wid + 8 && (!first || kt >= 8))) {
            if (masked && (kt == wid || kt == wid + 8)) {
#pragma unroll
                for (int j = 0; j < 4; ++j) { const int key = 16 * kt + 4 * quad + j; if (!(key >= qi && key <= qi + 128)) s[kt][j] = -1.0e30f; }
            }
            mx = fmaxf(mx, fmaxf(fmaxf(s[kt][0], s[kt][1]), fmaxf(s[kt][2], s[kt][3])));
        }
    }
    mx = fmaxf(mx, __shfl_xor(mx, 16)); mx = fmaxf(mx, __shfl_xor(mx, 32));
    const float nb = -mx * SC;
    float sum = 0.f;
#pragma unroll
    for (int kt = 0; kt < 16; ++kt) {
        if (!masked || (kt >= wid && kt <= wid + 8 && (!first || kt >= 8))) {
#pragma unroll
            for (int j = 0; j < 4; ++j) { const float pp_ = __builtin_amdgcn_exp2f(fmaf(s[kt][j], SC, nb)); s[kt][j] = pp_; sum += pp_; }
        }
    }
    sum += __shfl_xor(sum, 16); sum += __shfl_xor(sum, 32);
    bf16x8 pb[8];
#pragma unroll
    for (int t = 0; t < 8; ++t) { u32x4 w; w.x = cvt_pk_bf16(s[2 * t][0], s[2 * t][1]); w.y = cvt_pk_bf16(s[2 * t][2], s[2 * t][3]);
        w.z = cvt_pk_bf16(s[2 * t + 1][0], s[2 * t + 1][1]); w.w = cvt_pk_bf16(s[2 * t + 1][2], s[2 * t + 1][3]); pb[t] = __builtin_bit_cast(bf16x8, w); }
    const float inv = 1.0f / sum;
    bf16_t* orow = op + (size_t)qi * os + 4 * quad;
#pragma unroll
    for (int dt = 0; dt < 8; ++dt) {
        f32x4 a = (f32x4){0.f, 0.f, 0.f, 0.f};
#pragma unroll
        for (int t = 0; t < 8; ++t) {
            if (!masked || (2 * t + 1 >= wid && 2 * t <= wid + 8)) {
                const int pt = (t + 4 * p) & 7;
                const LAS unsigned char* vr = Vt + (16 * dt + l15) * VT_PITCH + (32 * pt + 4 * quad) * 2;
                const u32x2 lo = *(const LAS u32x2*)vr, hi = *(const LAS u32x2*)(vr + 32);
                u32x4 w; w.x = lo.x; w.y = lo.y; w.z = hi.x; w.w = hi.y;
                a = __builtin_amdgcn_mfma_f32_16x16x32_bf16(__builtin_bit_cast(bf16x8, w), pb[t], a, 0, 0, 0);
            }
        }
        u32x2 w; w.x = cvt_pk_bf16(a[0] * inv, a[1] * inv); w.y = cvt_pk_bf16(a[2] * inv, a[3] * inv);
        *(u32x2*)(orow + 16 * dt) = w;
    }
    if (lp && quad == 0) lp[(size_t)qi * ls] = (mx * SC + __log2f(sum)) * 0.6931471805599453f;
}
__device__ __forceinline__ void attn_run(LAS unsigned char* lds, int n0, int nit, const bf16_t* qp, unsigned qbs, unsigned qs, const bf16_t* kp, const bf16_t* vp, unsigned kbs, unsigned kvs,
                                         bf16_t* op, unsigned obs, unsigned os, float* lp, unsigned lbs, unsigned ls, bool masked, int tid) {
    HalfRegs hr; bf16x8 qf[4];
    __syncthreads();
    {
        HalfRegs h2;
        if (kbs == 0) {
            half_fetch(hr, kp, vp, kvs, tid); half_fetch(h2, kp + (size_t)128 * kvs, vp + (size_t)128 * kvs, kvs, tid);
            q_fetch(qf, qp + (size_t)n0 * qbs, qs, tid);
            half_commit(hr, lds, 0, tid); half_commit(h2, lds, 1, tid);
        } else {
            const int mprev = n0 > 0 ? n0 - 1 : 0;
            half_fetch(hr, kp + (size_t)mprev * kbs, vp + (size_t)mprev * kbs, kvs, tid); half_fetch(h2, kp + (size_t)n0 * kbs, vp + (size_t)n0 * kbs, kvs, tid);
            q_fetch(qf, qp + (size_t)n0 * qbs, qs, tid);
            half_commit(hr, lds, (n0 - 1) & 1, tid); half_commit(h2, lds, n0 & 1, tid);
        }
    }
    __syncthreads();
#pragma unroll 1
    for (int j = 0; j < nit; ++j) {
        const int n = n0 + j; const bool more = j + 1 < nit;
        if (more && kbs != 0) half_fetch(hr, kp + (size_t)(n + 1) * kbs, vp + (size_t)(n + 1) * kbs, kvs, tid);
        attn_compute(lds, qf, kbs == 0 ? 0 : ((n - 1) & 1), op + (size_t)n * obs, os, lp ? lp + (size_t)n * lbs : nullptr, ls, masked, masked && n == 0, tid);
        if (more) {
            __syncthreads();
            q_fetch(qf, qp + (size_t)(n + 1) * qbs, qs, tid);
            if (kbs != 0) half_commit(hr, lds, (n + 1) & 1, tid);
            __syncthreads();
        }
    }
}

__device__ __forceinline__ void sgu_item(LAS unsigned char* lds, const bf16_t* proj, const u64* stats, const float* lng, const float* lnb,
                                         const bf16_t* wsp, const float* bsp, bf16_t* cat, int n, int g, int tid) {
    const int wid = __builtin_amdgcn_readfirstlane(tid >> 6), lane = tid & 63, l15 = lane & 15, quad = lane >> 4;
    LAS unsigned char* Vt = lds + VT_OFF;
    __syncthreads();
    bf16x8 wf[4];
    { const bf16_t* wrow = wsp + (size_t)g * 16384 + (size_t)(16 * wid + l15) * 128 + 8 * quad;
#pragma unroll
      for (int ks = 0; ks < 4; ++ks) wf[ks] = *(const bf16x8*)(wrow + 32 * ks); }
    { const int cl = lane & 3, pair = (lane >> 2) + 16 * (wid & 3);
      const int row0 = 128 * n + 2 * pair;
      const f32x2 st0 = (f32x2){fs_get(stats + 2 * row0), fs_get(stats + 2 * row0 + 1)}, st1 = (f32x2){fs_get(stats + 2 * row0 + 2), fs_get(stats + 2 * row0 + 3)};
      const float mu0 = st0.x * (1.0f / 1536.0f), mu1 = st1.x * (1.0f / 1536.0f);
      const float rs0 = rsqrtf(fmaxf(st0.y * (1.0f / 1536.0f) - mu0 * mu0, 0.f) + 1e-5f), rs1 = rsqrtf(fmaxf(st1.y * (1.0f / 1536.0f) - mu1 * mu1, 0.f) + 1e-5f);
      const bf16_t* v0 = proj + (size_t)row0 * NIN1 + 1536 + 128 * g;
#pragma unroll
      for (int i = 0; i < 2; ++i) { const int c = cl + 4 * ((wid >> 2) + 2 * i);
          const u32x4 a = *(const u32x4*)(v0 + 8 * c), b = *(const u32x4*)(v0 + NIN1 + 8 * c);
          const f32x4 g0 = *(const f32x4*)(lng + 128 * g + 8 * c), g1 = *(const f32x4*)(lng + 128 * g + 8 * c + 4);
          const f32x4 b0 = *(const f32x4*)(lnb + 128 * g + 8 * c), b1 = *(const f32x4*)(lnb + 128 * g + 8 * c + 4);
          const unsigned aw[4] = {a.x, a.y, a.z, a.w}, bw[4] = {b.x, b.y, b.z, b.w};
          const float gg[8] = {g0.x, g0.y, g0.z, g0.w, g1.x, g1.y, g1.z, g1.w}, bb[8] = {b0.x, b0.y, b0.z, b0.w, b1.x, b1.y, b1.z, b1.w};
          LAS unsigned char* dst = Vt + (8 * c) * VT_PITCH + 4 * pair;
#pragma unroll
          for (int e = 0; e < 8; ++e) {
              const float xa = (e & 1) ? bf_hi(aw[e >> 1]) : bf_lo(aw[e >> 1]);
              const float xb = (e & 1) ? bf_hi(bw[e >> 1]) : bf_lo(bw[e >> 1]);
              const float ya = (xa - mu0) * rs0 * gg[e] + bb[e], yb = (xb - mu1) * rs1 * gg[e] + bb[e];
              *(LAS unsigned*)(dst + e * VT_PITCH) = cvt_pk_bf16(ya, yb);
          } } }
    __syncthreads();
    const int t = 16 * wid + l15;
    const float bias = bsp[g * 128 + t];
    const size_t grow = (size_t)(128 * n + t);
    const bf16_t* urow = proj + grow * NIN1 + 128 * g + 4 * quad;
    bf16_t* orow = cat + grow * 2048 + 128 * g + 4 * quad;
#pragma unroll
    for (int ct = 0; ct < 8; ++ct) {
        f32x4 a = (f32x4){0.f, 0.f, 0.f, 0.f};
#pragma unroll
        for (int ks = 0; ks < 4; ++ks) {
            if (32 * ks <= 16 * wid + 15) {
                const bf16x8 vf = *(const LAS bf16x8*)(Vt + (16 * ct + l15) * VT_PITCH + ks * 64 + quad * 16);
                a = __builtin_amdgcn_mfma_f32_16x16x32_bf16(vf, wf[ks], a, 0, 0, 0);
            }
        }
        const u32x2 uu = *(const u32x2*)(urow + 16 * ct);
        u32x2 w; w.x = cvt_pk_bf16((a[0] + bias) * bf_lo(uu.x), (a[1] + bias) * bf_hi(uu.x)); w.y = cvt_pk_bf16((a[2] + bias) * bf_lo(uu.y), (a[3] + bias) * bf_hi(uu.y));
        *(u32x2*)(orow + 16 * ct) = w;
    }
}

#define XB_TMO      128
#define XB_XCNT(j)  (256  + 64 * (j))
#define XB_XSUB(j)  (1280 + 64 * (j))
#define XB_XGEN(j)  (2304 + 64 * (j))
#define XB_TOP      3328
#define XB_TOPGEN   3392
#define XCD_BAR_WORDS 3456
#define XB_SPIN_CAP (1u << 18)
__device__ __forceinline__ unsigned xb_ld(unsigned* p)              { return __hip_atomic_load(p, __ATOMIC_RELAXED, __HIP_MEMORY_SCOPE_AGENT); }
__device__ __forceinline__ unsigned xb_add(unsigned* p, unsigned v) { return __hip_atomic_fetch_add(p, v, __ATOMIC_RELAXED, __HIP_MEMORY_SCOPE_AGENT); }
__device__ __forceinline__ unsigned xb_xcc_id() { return (unsigned)__builtin_amdgcn_s_getreg((3 << 11) | 20) & 0xFu; }
#define XB_SPIN(cond, bar) do { unsigned _sp = 0; while (cond) { __builtin_amdgcn_s_sleep(1); \
    if ((++_sp & 255u) == 0u) { if (xb_ld(&(bar)[XB_TMO])) break; if (_sp > XB_SPIN_CAP) { atomicAdd(&(bar)[XB_TMO], 1u); break; } } } } while (0)
struct XcdBarrier { unsigned* bar; unsigned x; volatile LAS unsigned* st; };
__device__ __forceinline__ XcdBarrier xcd_barrier_post(unsigned* bar, volatile LAS unsigned* st) {
    XcdBarrier b; b.bar = bar; b.x = xb_xcc_id(); b.st = st;
    if (threadIdx.x == 0) (void)xb_add(&bar[XB_XCNT(b.x)], 1u);
    return b;
}
__device__ __forceinline__ void xcd_barrier_complete(unsigned* bar, unsigned x, unsigned& nloc, unsigned& nx) {
    const unsigned G = gridDim.x * gridDim.y * gridDim.z;
    unsigned sum, cnt, mine, sp = 0u;
    for (;;) {
        sum = 0u; cnt = 0u; mine = 0u;
#pragma unroll
        for (unsigned j = 0; j < 16; ++j) { const unsigned c = xb_ld(&bar[XB_XCNT(j)]); sum += c; cnt += (c > 0u) ? 1u : 0u; mine = (j == x) ? c : mine; }
        if (sum == G) break;
        __builtin_amdgcn_s_sleep(1);
        if ((++sp & 255u) == 0u) { if (xb_ld(&bar[XB_TMO])) break; if (sp > XB_SPIN_CAP) { atomicAdd(&bar[XB_TMO], 1u); break; } }
    }
    nloc = mine > 0u ? mine : 1u; nx = cnt > 0u ? cnt : 1u;
}
__device__ __forceinline__ void xcd_barrier(const XcdBarrier& b) {
    asm volatile("s_waitcnt vmcnt(0)" ::: "memory");
    __syncthreads();
    if (threadIdx.x == 0) {
        unsigned* bar = b.bar;
        __builtin_amdgcn_s_waitcnt(0);
        unsigned nloc = b.st[0], nx = b.st[1];
        if (nloc == 0u) { xcd_barrier_complete(bar, b.x, nloc, nx); b.st[0] = nloc; b.st[1] = nx; }
        const unsigned old = xb_add(&bar[XB_XSUB(b.x)], 1u);
        const unsigned gen = old / nloc;
        if (old + 1u == (gen + 1u) * nloc) {
            __builtin_amdgcn_fence(__ATOMIC_RELEASE, "agent");
            asm volatile("s_waitcnt vmcnt(0)" ::: "memory");
            const unsigned og = xb_add(&bar[XB_TOP], 1u);
            const unsigned tg = og / nx;
            if (og + 1u == (tg + 1u) * nx) xb_add(&bar[XB_TOPGEN], 1u);
            else XB_SPIN(xb_ld(&bar[XB_TOPGEN]) == tg, bar);
            __builtin_amdgcn_fence(__ATOMIC_ACQUIRE, "agent");
            xb_add(&bar[XB_XGEN(b.x)], 1u);
            asm volatile("s_waitcnt vmcnt(0)" ::: "memory");
        } else {
            XB_SPIN(xb_ld(&bar[XB_XGEN(b.x)]) == gen, bar);
            __builtin_amdgcn_fence(__ATOMIC_ACQUIRE, "agent");
            asm volatile("s_waitcnt vmcnt(0)" ::: "memory");
        }
    }
    __syncthreads();
}

enum { K_PREP = 0, K_GEMM_BF = 1, K_MIX = 2, K_MERGE = 3, K_GEMM_RES = 4, K_NORM = 5, K_GEMM_GU = 6 };
constexpr unsigned long long KINDS = 0x0ull | (1ull << 4) | (2ull << 8) | (3ull << 12) | (4ull << 16) | (6ull << 20) | (4ull << 24) | (1ull << 28) | (2ull << 32) | (4ull << 36) |
                                     (6ull << 40) | (4ull << 44) | (5ull << 48);
constexpr int NSTEPS = 13;
#ifndef ENMASK
#define ENMASK 0x7f
#endif
#ifndef REP_MASK
#define REP_MASK 0
#endif
#ifndef SYNC_REP
#define SYNC_REP 1
#endif

__global__ void __launch_bounds__(512, 2) fwd_megakernel(Params p) {
    extern __shared__ __attribute__((aligned(16))) unsigned char lds_raw[];
    LAS unsigned char* lds = (LAS unsigned char*)lds_raw;
    cg::grid_group grid = cg::this_grid();
    const int G = gridDim.x, bid = blockIdx.x;
    if (threadIdx.x < 4) ((LAS unsigned*)(lds + LDS_CTL))[threadIdx.x] = 0u;
    __syncthreads();
    if (p.ws == nullptr) grid.sync();
    const XcdBarrier xbar = xcd_barrier_post((unsigned*)(p.ws + O_BAR), (volatile LAS unsigned*)(lds + LDS_CTL));
#pragma unroll 1
    for (int step = 0; step < NSTEPS; ++step) {
        const int kind = (int)((KINDS >> (4 * step)) & 15ull);
        const int layer = (step >= 7) ? 1 : 0;
        const bool idem = (kind == K_PREP) || (kind == K_MIX) || (kind == K_MERGE) || (kind == K_NORM) || (kind == K_GEMM_GU) || (kind == K_GEMM_BF && layer == 0);
        const int nrep = (REP_MASK != 0 && ((REP_MASK >> kind) & 1) && idem) ? 2 : 1;
#pragma unroll 1
        for (int rep = 0; rep < nrep; ++rep) {
        int tid = threadIdx.x; asm volatile("" : "+v"(tid));
        const Params __attribute__((address_space(4)))* pp = (const Params __attribute__((address_space(4)))*)__builtin_amdgcn_kernarg_segment_ptr();
        asm volatile("" : "+s"(pp));
        unsigned char* ws = pp->ws;
        const int lane = tid & 63, wave = __builtin_amdgcn_readfirstlane(tid >> 6);
        bf16_t* WIN0 = (bf16_t*)(ws + O_WIN0); bf16_t* WOUT0 = (bf16_t*)(ws + O_WOUT0); bf16_t* WIN1 = (bf16_t*)(ws + O_WIN1); bf16_t* WOUT1 = (bf16_t*)(ws + O_WOUT1);
        bf16_t* WGU = (bf16_t*)(ws + O_WGU); bf16_t* WDN = (bf16_t*)(ws + O_WDN); bf16_t* WKV = (bf16_t*)(ws + O_WKV); bf16_t* WSP = (bf16_t*)(ws + O_WSP);
        bf16_t* H = (bf16_t*)(ws + O_H); bf16_t* AO = (bf16_t*)(ws + O_H); bf16_t* BIG = (bf16_t*)(ws + O_BIG); bf16_t* CAT = (bf16_t*)(ws + O_CAT);
        float* LSE = (float*)(ws + O_LSE); bf16_t* MEMN = (bf16_t*)(ws + O_MEMN); bf16_t* MEMKV = (bf16_t*)(ws + O_MEMKV); float* ROPE = (float*)(ws + O_ROPE); u64* STATS = (u64*)(ws + O_STATS); u64* SS = (u64*)(ws + O_SS);

        int cv_lo = 0, cv_hi = 0, cv_w0 = 0, cv_nw = 1;
        switch (kind) {
        case K_PREP: if constexpr ((ENMASK >> 0) & 1) {
            const int gw = bid * 8 + wave, NGW = G * 8;
            cv_lo = 0; cv_hi = CV_PREP; cv_w0 = gw; cv_nw = NGW;
            for (int m = gw; m < SEQ + 512; m += NGW) {
                if (m < SEQ) rms_row(pp->x + (size_t)m * DM, pp->mix_norm, H + (size_t)m * DM, nullptr, lane);
                else { const int mm = m - SEQ, l = mm >> 8, r = mm & 255; rms_row(pp->mem + (size_t)r * DM, pp->mem_norm + l * DM, MEMN + (size_t)mm * DM, nullptr, lane); }
            }
            const int gt = bid * 512 + tid, NGT = G * 512;
            for (int i = gt; i < SEQ * 16; i += NGT) {
                const int t = i >> 4, f = i & 15;
                const float inv = exp2f(-(float)f * 1.1832230355827609f);
                const float ang = (float)pp->pos[t] * inv;
                const float k = rintf(ang * 0.15915494309189535f);
                float r = fmaf(-k, 6.28125f, ang); r = fmaf(-k, 0.0019353071795864769f, r);
                ROPE[2 * i] = __cosf(r); ROPE[2 * i + 1] = __sinf(r);
            }
            for (int i = gt; i < SEQ * 6; i += NGT) STATS[i] = 0u;
            for (int i = gt; i < 12 * 128 * 128; i += NGT) { const int tt = (i >> 7) & 127, ss = i & 127; const float w = (ss <= tt) ? pp->sgu_w_spatial[i] : 0.f; WSP[i] = (bf16_t)(cvt_pk_bf16(w, 0.f) & 0xffffu); }
        } break;
        case K_GEMM_BF: if constexpr ((ENMASK >> 1) & 1) {
            const int nsub = layer ? 1 : 2;
#pragma unroll 1
            for (int sub = 0; sub < nsub; ++sub) {
                pg8::Gemm g; pg8::Order S; pg8::EpiBf E;
                if (layer == 0 && sub == 0) { g = pg8::Gemm{H, WIN0, SEQ, NIN0, DM}; S.init(SEQ, NIN0, G, bid, 0); E = pg8::EpiBf{BIG, NIN0, 12, 0, 0, 0, ROPE, STATS, nullptr}; }
                else if (layer == 0) { g = pg8::Gemm{MEMN, WKV, 512, 2048, DM}; S.init(512, 2048, G, bid, 1); E = pg8::EpiBf{MEMKV, 2048, 0, 0, 0, 0, ROPE, STATS, nullptr}; }
                else { g = pg8::Gemm{H, WIN1, SEQ, NIN1, DM}; S.init(SEQ, NIN1, G, bid, 0); E = pg8::EpiBf{BIG, NIN1, 0, 12, 6, 12, ROPE, STATS, SS + SEQ}; }
                pg8::gemm_phase<pg8::EpiBf>(lds, g, S, E);
            }
            if (rep == 0) {
                if (layer == 0) { if (bid >= 136) { cv_lo = CV_S5; cv_hi = CV_S1; cv_w0 = (bid - 136) * 8 + wave; cv_nw = (G - 136) * 8; } }
                else { if (bid >= 192) { cv_lo = CV_PREP; cv_hi = CV_S7; cv_w0 = (bid - 192) * 8 + wave; cv_nw = (G - 192) * 8; } }
            }
        } break;
        case K_MIX: if constexpr ((ENMASK >> 2) & 1) {
            if (layer == 0) {
                if (bid < 192) {
                    const int g = bid >> 6, rr = bid & 63, h = rr & 3, chain = rr >> 2;
                    const int d = (g == 0) ? 1 : ((g == 1) ? 4 : 16), rpr = 16 / d, r = chain / rpr, n0 = 4 * (chain - r * rpr);
                    const bf16_t* base = BIG + (size_t)r * NIN0 + (4 * g + h) * 128;
                    attn_run(lds, n0, 4, base, 128u * d * NIN0, (unsigned)d * NIN0, base + 1536, base + 3072, 128u * d * NIN0, (unsigned)d * NIN0,
                             AO + (size_t)g * SEQ * 512 + (size_t)r * 512 + h * 128, 128u * d * 512, (unsigned)d * 512,
                             LSE + (size_t)g * SEQ * 4 + (size_t)r * 4 + h, 128u * d * 4, (unsigned)d * 4, true, tid);
                } else {
                    const int mb = bid - 192, h = mb & 3, n0 = 4 * (mb >> 2);
                    const bf16_t* kv = MEMKV + h * 128;
                    attn_run(lds, n0, 4, BIG + 4608 + h * 128, 128u * NIN0, (unsigned)NIN0, kv, kv + 512, 0u, 2048u,
                             CAT + 512 + h * 128, 128u * 1024, 1024u, nullptr, 0u, 0u, false, tid);
                }
            } else {
#pragma unroll 1
                for (int it = bid; it < 1024; it += G) {
                    if (it >= 768) {
                        const int rem = it - 768, h = rem & 3, n = rem >> 2;
                        const bf16_t* kv = MEMKV + (size_t)256 * 2048 + 1024 + h * 128;
                        attn_run(lds, n, 1, BIG + 3072 + h * 128, 128u * NIN1, (unsigned)NIN1, kv, kv + 512, 0u, 2048u,
                                 CAT + 1536 + h * 128, 128u * 2048, 2048u, nullptr, 0u, 0u, false, tid);
                    } else {
                        const int g = it % 12, n = it / 12;
                        sgu_item(lds, BIG, STATS, pp->sgu_ln_g, pp->sgu_ln_b, WSP, pp->sgu_b_spatial, CAT, n, g, tid);
                    }
                }
            }
        } break;
        case K_MERGE: if constexpr ((ENMASK >> 3) & 1) {
            const int gt = bid * 512 + tid, NGT = G * 512;
#pragma unroll 1
            for (int i0 = gt; i0 < SEQ * 64; i0 += 4 * NGT) {
                float l0[4], l1[4], l2[4]; u32x4 a[4], b[4], c[4];
#pragma unroll
                for (int j = 0; j < 4; ++j) {
                    const int i = (i0 + j * NGT < SEQ * 64) ? i0 + j * NGT : i0;
                    const int t = i >> 6, rem = i & 63, h = rem >> 4, c8 = rem & 15;
                    l0[j] = LSE[(size_t)t * 4 + h]; l1[j] = LSE[(size_t)SEQ * 4 + t * 4 + h]; l2[j] = LSE[(size_t)2 * SEQ * 4 + t * 4 + h];
                    const size_t off = (size_t)t * 512 + h * 128 + c8 * 8;
                    a[j] = *(const u32x4*)(AO + off); b[j] = *(const u32x4*)(AO + (size_t)SEQ * 512 + off); c[j] = *(const u32x4*)(AO + (size_t)2 * SEQ * 512 + off);
                }
#pragma unroll
                for (int j = 0; j < 4; ++j) {
                    const int i = i0 + j * NGT;
                    if (i < SEQ * 64) {
                        const int t = i >> 6, rem = i & 63, h = rem >> 4, c8 = rem & 15;
                        const float m = fmaxf(l0[j], fmaxf(l1[j], l2[j]));
                        float w0 = __expf(l0[j] - m), w1 = __expf(l1[j] - m), w2 = __expf(l2[j] - m);
                        const float inv = 1.0f / (w0 + w1 + w2); w0 *= inv; w1 *= inv; w2 *= inv;
                        const u32x4 aa = a[j], bb = b[j], cc = c[j];
                        u32x4 o;
                        o.x = cvt_pk_bf16(w0 * bf_lo(aa.x) + w1 * bf_lo(bb.x) + w2 * bf_lo(cc.x), w0 * bf_hi(aa.x) + w1 * bf_hi(bb.x) + w2 * bf_hi(cc.x));
                        o.y = cvt_pk_bf16(w0 * bf_lo(aa.y) + w1 * bf_lo(bb.y) + w2 * bf_lo(cc.y), w0 * bf_hi(aa.y) + w1 * bf_hi(bb.y) + w2 * bf_hi(cc.y));
                        o.z = cvt_pk_bf16(w0 * bf_lo(aa.z) + w1 * bf_lo(bb.z) + w2 * bf_lo(cc.z), w0 * bf_hi(aa.z) + w1 * bf_hi(bb.z) + w2 * bf_hi(cc.z));
                        o.w = cvt_pk_bf16(w0 * bf_lo(aa.w) + w1 * bf_lo(bb.w) + w2 * bf_lo(cc.w), w0 * bf_hi(aa.w) + w1 * bf_hi(bb.w) + w2 * bf_hi(cc.w));
                        *(u32x4*)(CAT + (size_t)t * 1024 + h * 128 + c8 * 8) = o;
                    }
                }
            }
        } break;
        case K_GEMM_RES: if constexpr ((ENMASK >> 4) & 1) {
            pg8::Gemm g; pg8::EpiRes E{nullptr, H, SS};
            if (step == 4) { g = pg8::Gemm{CAT, WOUT0, SEQ, DM, 1024}; E.base32 = pp->x; }
            else if (step == 6) { g = pg8::Gemm{BIG, WDN, SEQ, DM, FF}; E.ss = SS + SEQ; }
            else if (step == 9) { g = pg8::Gemm{CAT, WOUT1, SEQ, DM, 2048}; E.ss = SS + 2 * SEQ; }
            else { g = pg8::Gemm{BIG, WDN + (size_t)2048 * 5632, SEQ, DM, FF}; E.ss = SS + 3 * SEQ; }
            pg8::Order S; S.init(SEQ, DM, G, bid, 0);
            pg8::gemm_phase<pg8::EpiRes>(lds, g, S, E);
        } break;
        case K_NORM: if constexpr ((ENMASK >> 5) & 1) {
            const int gw = bid * 8 + wave, NGW = G * 8;
            for (int m = gw; m < SEQ; m += NGW) {
                const float rstd = rsqrtf(fx_get(SS + 3 * SEQ + m) * (1.0f / 2048.0f) + 1e-6f);
                const u32x4* xr = (const u32x4*)(H + (size_t)m * DM) + lane; const f32x4* gr = (const f32x4*)pp->final_norm + 2 * lane; f32x4* orow = (f32x4*)(pp->out + (size_t)m * DM) + 2 * lane;
#pragma unroll
                for (int j = 0; j < 4; ++j) { const u32x4 w = xr[64 * j]; const f32x4 g0 = gr[128 * j], g1 = gr[128 * j + 1];
                    orow[128 * j] = (f32x4){bf_lo(w.x), bf_hi(w.x), bf_lo(w.y), bf_hi(w.y)} * rstd * g0; orow[128 * j + 1] = (f32x4){bf_lo(w.z), bf_hi(w.z), bf_lo(w.w), bf_hi(w.w)} * rstd * g1; }
            }
        } break;
        case K_GEMM_GU: if constexpr ((ENMASK >> 6) & 1) {
            pg8::Gemm g{H, WGU + (size_t)layer * 11264 * 2048, SEQ, 11264, DM};
            pg8::Order S; S.init(SEQ, 11264, G, bid, 0);
            pg8::EpiGU E{BIG, SS + (layer ? 2 * SEQ : 0)};
            pg8::gemm_phase<pg8::EpiGU>(lds, g, S, E);
            if (rep == 0 && bid >= 128) {
                if (layer == 0) { cv_lo = CV_S7; cv_hi = CV_S5; } else { cv_lo = CV_S1; cv_hi = CV_END; }
                cv_w0 = (bid - 128) * 8 + wave; cv_nw = (G - 128) * 8;
            }
        } break;
        default: break;
        }
        if (cv_hi > cv_lo) convert_tiles(pp, ws, cv_lo, cv_hi, cv_w0, cv_nw, (LAS float*)(lds + wave * 16640), lane);
        if (step + 1 < NSTEPS || rep + 1 < nrep) {
#pragma unroll 1
            for (int sr = 0; sr < SYNC_REP; ++sr) xcd_barrier(xbar);
        }
        }
    }
}

extern "C" void kernel_launch(void* const* d_in, const int* in_sizes, int n_in, void* d_out, int out_size, void* d_ws, size_t ws_size, hipStream_t stream) {
    static int grid_blocks = 0;
    if (grid_blocks == 0) {
        if (n_in != 19 || ws_size < WS_NEED || out_size != SEQ * DM) { fprintf(stderr, "kernel_launch: unexpected problem (n_in %d, ws %zu need %zu, out %d)\n", n_in, ws_size, (size_t)WS_NEED, out_size); grid_blocks = -1; return; }
        int dev = 0, cus = 0, per_cu = 0;
        (void)hipGetDevice(&dev);
        (void)hipDeviceGetAttribute(&cus, hipDeviceAttributeMultiprocessorCount, dev);
        if (hipFuncSetAttribute((const void*)fwd_megakernel, hipFuncAttributeMaxDynamicSharedMemorySize, LDS_BYTES) != hipSuccess) { fprintf(stderr, "kernel_launch: hipFuncSetAttribute failed\n"); grid_blocks = -1; return; }
        if (hipOccupancyMaxActiveBlocksPerMultiprocessor(&per_cu, (const void*)fwd_megakernel, 512, LDS_BYTES) != hipSuccess || per_cu < 1) { fprintf(stderr, "kernel_launch: occupancy query failed (%d)\n", per_cu); grid_blocks = -1; return; }
        grid_blocks = cus * 1;
    }
    if (grid_blocks < 0) return;
    Params p{};
    p.x = (const float*)d_in[0]; p.mem = (const float*)d_in[1]; p.pos = (const int*)d_in[2];
    p.mix_norm = (const float*)d_in[3]; p.mem_norm = (const float*)d_in[4]; p.w_mem_kv = (const float*)d_in[5]; p.ffn_norm = (const float*)d_in[6];
    p.w_gate = (const float*)d_in[7]; p.w_up = (const float*)d_in[8]; p.w_down = (const float*)d_in[9];
    p.attn_w_in = (const float*)d_in[10]; p.attn_w_out = (const float*)d_in[11]; p.sgu_w_in = (const float*)d_in[12]; p.sgu_ln_g = (const float*)d_in[13]; p.sgu_ln_b = (const float*)d_in[14];
    p.sgu_w_spatial = (const float*)d_in[15]; p.sgu_b_spatial = (const float*)d_in[16]; p.sgu_w_out = (const float*)d_in[17]; p.final_norm = (const float*)d_in[18];
    p.out = (float*)d_out; p.ws = (unsigned char*)d_ws;
    if (hipMemsetAsync(d_ws, 0, BAR_BYTES, stream) != hipSuccess) { fprintf(stderr, "kernel_launch: memset failed\n"); return; }
    void* args[] = {&p};
    hipError_t e = hipLaunchCooperativeKernel((const void*)fwd_megakernel, dim3(grid_blocks), dim3(512), args, LDS_BYTES, stream);
    if (e != hipSuccess) fprintf(stderr, "kernel_launch: cooperative launch failed: %s (grid %d)\n", hipGetErrorString(e), grid_blocks);
}
```

```cpp
#include <hip/hip_runtime.h>
#include <hip/hip_cooperative_groups.h>
#include <cstdio>
#include <cstddef>
namespace cg = cooperative_groups;

#define LAS __attribute__((address_space(3)))
typedef unsigned short bf16_t;
typedef short bf16x8 __attribute__((ext_vector_type(8)));
typedef short bf16x4 __attribute__((ext_vector_type(4)));
typedef float f32x4 __attribute__((ext_vector_type(4)));
typedef float f32x2 __attribute__((ext_vector_type(2)));
typedef unsigned u32x4 __attribute__((ext_vector_type(4)));
typedef unsigned u32x2 __attribute__((ext_vector_type(2)));

constexpr int SEQ = 8192, DM = 2048, FF = 5632;
constexpr int NIN0 = 5120, NIN1 = 3584;
constexpr int LDS_CTL = 140288;
constexpr int LDS_BYTES = LDS_CTL + 16;

constexpr size_t O_BAR = 0;
constexpr size_t BAR_BYTES = 16384;
constexpr size_t O_WIN0 = O_BAR + BAR_BYTES;
constexpr size_t O_WOUT0 = O_WIN0 + (size_t)5120 * 2048 * 2;
constexpr size_t O_WIN1 = O_WOUT0 + (size_t)2048 * 1024 * 2;
constexpr size_t O_WOUT1 = O_WIN1 + (size_t)3584 * 2048 * 2;
constexpr size_t O_WGU = O_WOUT1 + (size_t)2048 * 2048 * 2;
constexpr size_t O_WDN = O_WGU + (size_t)2 * 11264 * 2048 * 2;
constexpr size_t O_WKV = O_WDN + (size_t)2 * 2048 * 5632 * 2;
constexpr size_t O_WSP = O_WKV + (size_t)2 * 1024 * 2048 * 2;
constexpr size_t O_H = O_WSP + (size_t)12 * 128 * 128 * 2;
constexpr size_t O_BIG = O_H + (size_t)8192 * 2048 * 2;
constexpr size_t O_CAT = O_BIG + (size_t)8192 * 5632 * 2;
constexpr size_t O_LSE = O_CAT + (size_t)8192 * 2048 * 2;
constexpr size_t O_MEMN = O_LSE + (size_t)3 * 8192 * 4 * 4;
constexpr size_t O_MEMKV = O_MEMN + (size_t)512 * 2048 * 2;
constexpr size_t O_ROPE = O_MEMKV + (size_t)512 * 2048 * 2;
constexpr size_t O_STATS = O_ROPE + (size_t)8192 * 16 * 2 * 4;
constexpr size_t O_SS = O_STATS + (size_t)8192 * 2 * 4;
constexpr size_t WS_NEED = O_SS + (size_t)4 * 8192 * 4;
static_assert(WS_NEED < 459000000ull, "workspace map too large");

struct Params {
    const float* x; const float* mem; const int* pos;
    const float* mix_norm; const float* mem_norm; const float* w_mem_kv; const float* ffn_norm;
    const float* w_gate; const float* w_up; const float* w_down;
    const float* attn_w_in; const float* attn_w_out; const float* sgu_w_in; const float* sgu_ln_g; const float* sgu_ln_b;
    const float* sgu_w_spatial; const float* sgu_b_spatial; const float* sgu_w_out; const float* final_norm;
    float* out; unsigned char* ws;
};

#define LDS_WAIT() asm volatile("s_waitcnt lgkmcnt(0)" ::: "memory")
__device__ __forceinline__ unsigned cvt_pk_bf16(float lo, float hi) { unsigned r; asm volatile("v_cvt_pk_bf16_f32 %0, %1, %2" : "=v"(r) : "v"(lo), "v"(hi)); return r; }
__device__ __forceinline__ float bf_lo(unsigned w) { return __uint_as_float(w << 16); }
__device__ __forceinline__ float bf_hi(unsigned w) { return __uint_as_float(w & 0xffff0000u); }
typedef unsigned u64;
__device__ __forceinline__ void fx_add(u64* p, float v) { atomicAdd(p, __float2uint_rn(v * 16384.0f)); }
__device__ __forceinline__ float fx_get(const u64* p) { return (float)(*p) * (1.0f / 16384.0f); }
__device__ __forceinline__ void fs_add(u64* p, float v) { atomicAdd((int*)p, __float2int_rn(v * 65536.0f)); }
__device__ __forceinline__ float fs_get(const u64* p) { return (float)(*(const int*)p) * (1.0f / 65536.0f); }
__device__ __forceinline__ float wave_sum(float v) {
#pragma unroll
    for (int o = 1; o < 64; o <<= 1) v += __shfl_xor(v, o);
    return v;
}
__device__ __forceinline__ float gelu_tanh(float x) {
    const float z2 = 1.5957691216057308f * (x + 0.044715f * x * x * x);
    return x * __builtin_amdgcn_rcpf(1.0f + __expf(-z2));
}
__device__ __forceinline__ float silu(float x) { return x * __builtin_amdgcn_rcpf(1.0f + __expf(-x)); }

namespace pg8 {
constexpr int BM = 256, BK = 64, HALF = 128, HTB = HALF * BK * 2, STAGE_BYTES = 8 * HTB, NXCD = 8, WGM = 4;
__device__ __forceinline__ int lds_byte(int r, int c) { const int st = (r >> 4) * 2 + (c >> 5), rr = r & 15, cc = c & 31, ob = rr * 64 + cc * 2; return st * 1024 + (ob ^ (((ob >> 9) & 1) << 5)); }
__device__ __forceinline__ void stage_rc(int b, int& R, int& C) { const int st = b / 1024, sb = b % 1024, swz = sb ^ (((sb >> 9) & 1) << 5); R = (st >> 1) * 16 + swz / 64; C = (st & 1) * 32 + (swz % 64) / 2; }
__device__ __forceinline__ int perm32(int rho) { const int n = rho >> 4, i = rho & 15; return 8 * (i >> 2) + 4 * n + (i & 3); }

struct Unit { int pm, pn; };
struct Gemm { const bf16_t* A; const bf16_t* Bt; int M, N, K; };
struct Order {
    int nM, nN, nwg, G, c, mode;
    __device__ void init(int M, int N, int G_, int c_, int mode_) { nM = M / BM; nN = N / BM; nwg = nM * nN; G = G_; c = c_; mode = mode_; }
    __device__ bool next(int i, Unit& u) const {
        if (mode == 1) { if (i != 0 || c < 128 || c >= 136) return false; u.pm = (c - 128) >> 2; u.pn = ((c - 128) & 3) + 4 * u.pm; return true; }
        const long L = (long)i * G + c; if (L >= nwg) return false;
        int wgid = (int)L; { const int q = nwg / NXCD, r = nwg % NXCD, xcd = wgid % NXCD, off = wgid / NXCD; wgid = (xcd < r ? xcd * (q + 1) : r * (q + 1) + (xcd - r) * q) + off; }
        const int nig = WGM * nN, gid = wgid / nig, fm = gid * WGM, gsz = (nM - fm) < WGM ? (nM - fm) : WGM;
        u.pm = fm + ((wgid % nig) % gsz); u.pn = (wgid % nig) / gsz; return true;
    }
};

struct EpiBf {
    static constexpr bool PERM = true;
    bf16_t* O; int ldc; int n_rot, n_gelu, st_lo, st_hi; const float* rope; u64* stats; const u64* ss;
    __device__ __forceinline__ void operator()(const f32x4 (&acc)[2][2][4][2], const Unit& u, int wr, int wc, int fr, int fq) const {
        const int row0 = u.pm * BM + wr * 64 + fr, col0 = u.pn * BM + wc * 32 + 8 * fq;
        const bool rot = (u.pn < n_rot) && (wc == 0), gel = u.pn < n_gelu, st = (u.pn >= st_lo) && (u.pn < st_hi);
        const float sgn = (fq < 2) ? -1.0f : 1.0f;
        float rstd[8];
#pragma unroll
        for (int i = 0; i < 8; ++i) rstd[i] = ss ? fx_get(ss + row0 + (i >> 2) * HALF + (i & 3) * 16) : 0.f;
#pragma unroll
        for (int i = 0; i < 8; ++i) rstd[i] = ss ? rsqrtf(rstd[i] * (1.0f / 2048.0f) + 1e-6f) : 1.0f;
#pragma unroll
        for (int ai = 0; ai < 2; ++ai)
#pragma unroll
            for (int m = 0; m < 4; ++m) {
                const int i = ai * 4 + m, row = row0 + ai * HALF + m * 16;
                f32x4 cs[4];
                if (rot) {
                    const f32x4* rp = (const f32x4*)(rope + (size_t)row * 32 + 16 * (fq & 1));
#pragma unroll
                    for (int q = 0; q < 4; ++q) cs[q] = rp[q];
                }
                float rs = 0.f, rq = 0.f;
#pragma unroll
                for (int bj = 0; bj < 2; ++bj) {
                    float v[8];
#pragma unroll
                    for (int j = 0; j < 4; ++j) { v[j] = acc[ai][bj][m][0][j] * rstd[i]; v[4 + j] = acc[ai][bj][m][1][j] * rstd[i]; }
                    if (rot) {
#pragma unroll
                        for (int e = 0; e < 8; ++e) {
                            const float p = __shfl_xor(v[e], 32);
                            const float c = cs[e >> 1][(e & 1) * 2], sn = cs[e >> 1][(e & 1) * 2 + 1];
                            v[e] = v[e] * c + sgn * p * sn;
                        }
                    }
                    if (gel) {
#pragma unroll
                        for (int e = 0; e < 8; ++e) v[e] = gelu_tanh(v[e]);
                    }
                    if (st) {
#pragma unroll
                        for (int e = 0; e < 8; ++e) { rs += v[e]; rq += v[e] * v[e]; }
                    }
                    u32x4 w; w.x = cvt_pk_bf16(v[0], v[1]); w.y = cvt_pk_bf16(v[2], v[3]); w.z = cvt_pk_bf16(v[4], v[5]); w.w = cvt_pk_bf16(v[6], v[7]);
                    *(u32x4*)(O + (size_t)row * ldc + col0 + bj * HALF) = w;
                }
                if (st) {
                    rs += __shfl_xor(rs, 16); rs += __shfl_xor(rs, 32);
                    rq += __shfl_xor(rq, 16); rq += __shfl_xor(rq, 32);
                    if (fq == 0) { fs_add(stats + 2 * row, rs); fs_add(stats + 2 * row + 1, rq); }
                }
            }
    }
};
struct EpiRes {
    static constexpr bool PERM = true;
    const float* base32; bf16_t* xb; u64* ss;
    __device__ __forceinline__ void load32(f32x4 (&b)[2][2], size_t off) const {
#pragma unroll
        for (int bj = 0; bj < 2; ++bj)
#pragma unroll
            for (int n = 0; n < 2; ++n) b[bj][n] = __builtin_nontemporal_load((const f32x4*)(base32 + off + bj * HALF + n * 4));
    }
    __device__ __forceinline__ void operator()(const f32x4 (&acc)[2][2][4][2], const Unit& u, int wr, int wc, int fr, int fq) const {
        const int row0 = u.pm * BM + wr * 64 + fr, col0 = u.pn * BM + wc * 32 + 8 * fq;
        f32x4 b[2][2], bn[2][2];
        if (base32) load32(bn, (size_t)row0 * 2048 + col0);
#pragma unroll
        for (int ai = 0; ai < 2; ++ai) {
#pragma unroll
            for (int m = 0; m < 4; ++m) {
                const int row = row0 + ai * HALF + m * 16;
                const size_t off = (size_t)row * 2048 + col0;
                if (base32) {
#pragma unroll
                    for (int bj = 0; bj < 2; ++bj)
#pragma unroll
                        for (int n = 0; n < 2; ++n) b[bj][n] = bn[bj][n];
                    const int i1 = ai * 4 + m + 1;
                    if (i1 < 8) load32(bn, (size_t)(row0 + (i1 >> 2) * HALF + (i1 & 3) * 16) * 2048 + col0);
                } else {
#pragma unroll
                    for (int bj = 0; bj < 2; ++bj) { const u32x4 w = *(const u32x4*)(xb + off + bj * HALF);
                        b[bj][0] = (f32x4){bf_lo(w.x), bf_hi(w.x), bf_lo(w.y), bf_hi(w.y)}; b[bj][1] = (f32x4){bf_lo(w.z), bf_hi(w.z), bf_lo(w.w), bf_hi(w.w)}; }
                }
                float q = 0.f;
#pragma unroll
                for (int bj = 0; bj < 2; ++bj) {
                    const f32x4 v0 = b[bj][0] + acc[ai][bj][m][0], v1 = b[bj][1] + acc[ai][bj][m][1];
                    q += (v0.x * v0.x + v0.y * v0.y) + (v0.z * v0.z + v0.w * v0.w) + (v1.x * v1.x + v1.y * v1.y) + (v1.z * v1.z + v1.w * v1.w);
                    u32x4 w; w.x = cvt_pk_bf16(v0.x, v0.y); w.y = cvt_pk_bf16(v0.z, v0.w); w.z = cvt_pk_bf16(v1.x, v1.y); w.w = cvt_pk_bf16(v1.z, v1.w);
                    *(u32x4*)(xb + off + bj * HALF) = w;
                }
                if (ss) { q += __shfl_xor(q, 16); q += __shfl_xor(q, 32); if (fq == 0) fx_add(ss + row, q); }
            }
        }
    }
};
struct EpiGU {
    static constexpr bool PERM = true;
    bf16_t* O; const u64* ss;
    __device__ __forceinline__ void operator()(const f32x4 (&acc)[2][2][4][2], const Unit& u, int wr, int wc, int fr, int fq) const {
        const int row0 = u.pm * BM + wr * 64 + fr, col0 = u.pn * HALF + wc * 32 + 8 * fq;
        float rs8[8];
#pragma unroll
        for (int i = 0; i < 8; ++i) rs8[i] = fx_get(ss + row0 + (i >> 2) * HALF + (i & 3) * 16);
#pragma unroll
        for (int ai = 0; ai < 2; ++ai)
#pragma unroll
            for (int m = 0; m < 4; ++m) {
                const float rstd = rsqrtf(rs8[ai * 4 + m] * (1.0f / 2048.0f) + 1e-6f);
                float v[8];
#pragma unroll
                for (int n = 0; n < 2; ++n)
#pragma unroll
                    for (int j = 0; j < 4; ++j) v[4 * n + j] = silu(acc[ai][0][m][n][j] * rstd) * (acc[ai][1][m][n][j] * rstd);
                u32x4 w; w.x = cvt_pk_bf16(v[0], v[1]); w.y = cvt_pk_bf16(v[2], v[3]); w.z = cvt_pk_bf16(v[4], v[5]); w.w = cvt_pk_bf16(v[6], v[7]);
                *(u32x4*)(O + (size_t)(row0 + ai * HALF + m * 16) * FF + col0) = w;
            }
    }
};

template <class Epi, bool ALIGN_EPI = true, bool SP2 = true>
__device__ __forceinline__ void gemm_phase(LAS unsigned char* lds, const Gemm g, const Order& S, const Epi& E) {
    const int tid = threadIdx.x, wid = __builtin_amdgcn_readfirstlane(tid >> 6), lane = tid & 63, wr = wid >> 2, wc = wid & 3, fr = lane & 15, fq = lane >> 4;
    const int K = g.K, nt = K / BK;
    unsigned voffA[2], voffB[2];
#pragma unroll
    for (int i = 0; i < 2; ++i) { int R, C; stage_rc(tid * 16 + i * 8192, R, C); const int Rb = Epi::PERM ? ((R & ~31) + perm32(R & 31)) : R;
        voffA[i] = (unsigned)(R * K + C) * 2u; voffB[i] = (unsigned)(Rb * K + C) * 2u; }
    const unsigned kstep = (unsigned)(BK * 2);
    const unsigned hstep = (unsigned)HALF * (unsigned)K * 2u;
    const unsigned tstep = 2u * hstep;
    const __amdgpu_buffer_rsrc_t rA = __builtin_amdgcn_make_buffer_rsrc((void*)g.A, (short)0, (int)((unsigned)g.M * (unsigned)K * 2u), 0x00020000);
    const __amdgpu_buffer_rsrc_t rB = __builtin_amdgcn_make_buffer_rsrc((void*)g.Bt, (short)0, (int)((unsigned)g.N * (unsigned)K * 2u), 0x00020000);
    const unsigned ldsw = (unsigned)wid * 1024u;
    const int aoff = lds_byte(wr * 64 + fr, fq * 8), boff = lds_byte(wc * 32 + fr, fq * 8);
#define PG8_SA(b, h) (((b) * 2 + (h)) * HTB)
#define PG8_SB(b, h) ((4 + (b) * 2 + (h)) * HTB)
#define PG8_STAGE(bufoff, rsrc, soff, voff) do { _Pragma("unroll") for (int _i = 0; _i < 2; ++_i) \
        __builtin_amdgcn_raw_ptr_buffer_load_lds((rsrc), (LAS unsigned*)(lds + (bufoff) + ldsw + _i * 8192), 16, (int)(voff)[_i], (int)(soff), 0, 0); } while (0)
#define PG8_LDA(dst, b, h) do { _Pragma("unroll") for (int m = 0; m < 4; ++m) _Pragma("unroll") for (int k = 0; k < 2; ++k) dst[m][k] = *(const LAS bf16x8*)(lds + PG8_SA(b, h) + aoff + m * 2048 + k * 1024); } while (0)
#define PG8_LDB(dst, b, h) do { _Pragma("unroll") for (int n = 0; n < 2; ++n) _Pragma("unroll") for (int k = 0; k < 2; ++k) dst[n][k] = *(const LAS bf16x8*)(lds + PG8_SB(b, h) + boff + n * 2048 + k * 1024); } while (0)
#define PG8_MMA(ai, bj, At, Bt) do { __builtin_amdgcn_s_setprio(1); _Pragma("unroll") for (int m = 0; m < 4; ++m) _Pragma("unroll") for (int n = 0; n < 2; ++n) _Pragma("unroll") for (int k = 0; k < 2; ++k) \
        acc[ai][bj][m][n] = __builtin_amdgcn_mfma_f32_16x16x32_bf16(Bt[n][k], At[m][k], acc[ai][bj][m][n], 0, 0, 0); __builtin_amdgcn_s_setprio(0); } while (0)
#define PG8_WAIT_V(n) asm volatile("s_waitcnt vmcnt(" #n ")" ::: "memory")
#define PG8_WAIT_L(n) asm volatile("s_waitcnt lgkmcnt(" #n ")" ::: "memory")
#define PG8_BAR __builtin_amdgcn_s_barrier()
#define PG8_SCHED __builtin_amdgcn_sched_barrier(0)
    Unit cur, nxt; int ui = 0;
    if (!S.next(0, cur)) return;
    f32x4 acc[2][2][4][2];
#pragma unroll
    for (int a = 0; a < 2; ++a)
#pragma unroll
        for (int b = 0; b < 2; ++b)
#pragma unroll
            for (int m = 0; m < 4; ++m)
#pragma unroll
                for (int n = 0; n < 2; ++n) acc[a][b][m][n] = (f32x4){0.f, 0.f, 0.f, 0.f};
    bf16x8 At[4][2], B0[2][2], B1[2][2];
    unsigned cA = (unsigned)cur.pm * tstep, cB = (unsigned)cur.pn * tstep;
    if constexpr (SP2) {
        PG8_STAGE(PG8_SB(0, 0), rB, cB, voffB); PG8_STAGE(PG8_SB(0, 1), rB, cB + hstep, voffB); PG8_STAGE(PG8_SA(0, 0), rA, cA, voffA); PG8_STAGE(PG8_SA(0, 1), rA, cA + hstep, voffA);
        if (wr == 1) PG8_BAR;
        PG8_WAIT_V(2); PG8_BAR;
        PG8_STAGE(PG8_SB(1, 0), rB, cB + kstep, voffB); PG8_STAGE(PG8_SA(1, 0), rA, cA + kstep, voffA); PG8_STAGE(PG8_SB(1, 1), rB, cB + hstep + kstep, voffB);
        PG8_WAIT_V(6); PG8_BAR;
    } else {
        PG8_STAGE(PG8_SB(0, 0), rB, cB, voffB); PG8_STAGE(PG8_SA(0, 0), rA, cA, voffA); PG8_STAGE(PG8_SB(0, 1), rB, cB + hstep, voffB); PG8_STAGE(PG8_SA(0, 1), rA, cA + hstep, voffA);
        if (wr == 1) PG8_BAR;
        PG8_WAIT_V(4); PG8_BAR;
        PG8_STAGE(PG8_SB(1, 0), rB, cB + kstep, voffB); PG8_STAGE(PG8_SA(1, 0), rA, cA + kstep, voffA); PG8_STAGE(PG8_SB(1, 1), rB, cB + hstep + kstep, voffB);
        PG8_WAIT_V(6); PG8_BAR;
    }
    for (;;) {
        const bool has_next = S.next(ui + 1, nxt);
        const unsigned nA = has_next ? (unsigned)nxt.pm * tstep : cA, nB = has_next ? (unsigned)nxt.pn * tstep : cB;
        for (int t = 0; t < nt; t += 2) {
            const bool last = (t == nt - 2);
            const unsigned a1 = cA + (unsigned)(t + 1) * kstep;
            const unsigned a2 = last ? nA : cA + (unsigned)(t + 2) * kstep, b2 = last ? nB : cB + (unsigned)(t + 2) * kstep;
            const unsigned a3 = a2 + kstep, b3 = b2 + kstep;
            if constexpr (SP2) {
            PG8_LDB(B0, 0, 0); PG8_LDB(B1, 0, 1); PG8_SCHED; PG8_LDA(At, 0, 0); PG8_STAGE(PG8_SA(1, 1), rA, a1 + hstep, voffA);
            PG8_WAIT_V(8); PG8_WAIT_L(0); PG8_BAR; PG8_MMA(0, 0, At, B0); PG8_MMA(0, 1, At, B1); PG8_BAR; PG8_SCHED;
            PG8_LDA(At, 0, 1); PG8_STAGE(PG8_SB(0, 0), rB, b2, voffB); PG8_STAGE(PG8_SB(0, 1), rB, b2 + hstep, voffB); PG8_STAGE(PG8_SA(0, 0), rA, a2, voffA);
            PG8_WAIT_V(8); PG8_WAIT_L(0); PG8_BAR; PG8_MMA(1, 0, At, B0); PG8_MMA(1, 1, At, B1); PG8_BAR; PG8_SCHED;
            PG8_LDB(B0, 1, 0); PG8_LDB(B1, 1, 1); PG8_SCHED; PG8_LDA(At, 1, 0); PG8_STAGE(PG8_SA(0, 1), rA, a2 + hstep, voffA);
            PG8_WAIT_V(8); PG8_WAIT_L(0); PG8_BAR; PG8_MMA(0, 0, At, B0); PG8_MMA(0, 1, At, B1); PG8_BAR; PG8_SCHED;
            PG8_LDA(At, 1, 1); PG8_STAGE(PG8_SB(1, 0), rB, b3, voffB); PG8_STAGE(PG8_SB(1, 1), rB, b3 + hstep, voffB); PG8_STAGE(PG8_SA(1, 0), rA, a3, voffA);
            PG8_WAIT_V(8); PG8_WAIT_L(0); PG8_BAR; PG8_MMA(1, 0, At, B0); PG8_MMA(1, 1, At, B1); PG8_BAR; PG8_SCHED;
            } else {
            PG8_LDB(B0, 0, 0); PG8_SCHED; PG8_LDA(At, 0, 0); PG8_STAGE(PG8_SA(1, 1), rA, a1 + hstep, voffA);
            PG8_WAIT_L(8); PG8_BAR; PG8_WAIT_L(0); PG8_MMA(0, 0, At, B0); PG8_BAR; PG8_SCHED;
            PG8_LDB(B1, 0, 1); PG8_STAGE(PG8_SB(0, 0), rB, b2, voffB);
            PG8_BAR; PG8_WAIT_L(0); PG8_MMA(0, 1, At, B1); PG8_BAR;
            PG8_LDA(At, 0, 1); PG8_STAGE(PG8_SA(0, 0), rA, a2, voffA);
            PG8_BAR; PG8_WAIT_L(0); PG8_MMA(1, 0, At, B0); PG8_BAR; PG8_SCHED;
            PG8_STAGE(PG8_SB(0, 1), rB, b2 + hstep, voffB);
            PG8_WAIT_V(6); PG8_BAR; PG8_MMA(1, 1, At, B1); PG8_BAR;
            PG8_LDB(B0, 1, 0); PG8_SCHED; PG8_LDA(At, 1, 0); PG8_STAGE(PG8_SA(0, 1), rA, a2 + hstep, voffA);
            PG8_WAIT_L(8); PG8_BAR; PG8_WAIT_L(0); PG8_MMA(0, 0, At, B0); PG8_BAR; PG8_SCHED;
            PG8_LDB(B1, 1, 1); PG8_STAGE(PG8_SB(1, 0), rB, b3, voffB);
            PG8_BAR; PG8_WAIT_L(0); PG8_MMA(0, 1, At, B1); PG8_BAR;
            PG8_LDA(At, 1, 1); PG8_STAGE(PG8_SA(1, 0), rA, a3, voffA);
            PG8_BAR; PG8_WAIT_L(0); PG8_MMA(1, 0, At, B0); PG8_BAR; PG8_SCHED;
            PG8_STAGE(PG8_SB(1, 1), rB, b3 + hstep, voffB);
            PG8_WAIT_V(6); PG8_BAR; PG8_MMA(1, 1, At, B1); PG8_BAR;
            }
        }
        if constexpr (ALIGN_EPI) { if (wr == 0) PG8_BAR; }
        { int fr_e = (int)(threadIdx.x & 15u), fq_e = (int)((threadIdx.x >> 4) & 3u);
          asm volatile("" : "+v"(fr_e), "+v"(fq_e));
          E(acc, cur, wr, wc, fr_e, fq_e); }
        if (!has_next) break;
#pragma unroll
        for (int a = 0; a < 2; ++a)
#pragma unroll
            for (int b = 0; b < 2; ++b)
#pragma unroll
                for (int m = 0; m < 4; ++m)
#pragma unroll
                    for (int n = 0; n < 2; ++n) acc[a][b][m][n] = (f32x4){0.f, 0.f, 0.f, 0.f};
        cur = nxt; cA = nA; cB = nB; ++ui;
        if constexpr (ALIGN_EPI) { if (wr == 1) PG8_BAR; }
    }
    PG8_WAIT_V(0);
    if constexpr (!ALIGN_EPI) { if (wr == 0) PG8_BAR; }
    PG8_BAR;
#undef PG8_SA
#undef PG8_SB
#undef PG8_STAGE
#undef PG8_LDA
#undef PG8_LDB
#undef PG8_MMA
#undef PG8_WAIT_V
#undef PG8_WAIT_L
#undef PG8_BAR
#undef PG8_SCHED
}
}

constexpr int CV_PREP = 11456, CV_S7 = 13696, CV_S5 = 18176, CV_S1 = 20992, CV_END = 23808;
struct TileDesc { const float* src; bf16_t* dst; const float* gk; int N, K; };
__device__ __forceinline__ TileDesc tile_make(const float* W, int K, int N, bf16_t* WT, int mode, int r, const float* gain) {
    const int nblk = N >> 6, kb = r / nblk, nb = r - kb * nblk, n0 = nb * 64, k0 = kb * 64;
    int drow0 = n0;
    if (mode) drow0 = 256 * (n0 >> 7) + (n0 & 127) + (mode == 2 ? 128 : 0);
    TileDesc d; d.src = W + (size_t)k0 * N + n0; d.dst = WT + (size_t)drow0 * K + k0; d.gk = gain ? gain + k0 : nullptr; d.N = N; d.K = K; return d;
}
__device__ __forceinline__ TileDesc tile_decode(const Params __attribute__((address_space(4)))* pp, unsigned char* ws, int it) {
    constexpr int TG = 2816;
    int r = it;
    if (r < 2560) return tile_make(pp->attn_w_in, 2048, 5120, (bf16_t*)(ws + O_WIN0), 0, r, nullptr); r -= 2560;
    if (r < 512) return tile_make(pp->attn_w_out, 1024, 2048, (bf16_t*)(ws + O_WOUT0), 0, r, nullptr); r -= 512;
    if (r < 1024) { const int l = r >> 9; return tile_make(pp->w_mem_kv + (size_t)l * 2048 * 1024, 2048, 1024, (bf16_t*)(ws + O_WKV) + (size_t)l * 1024 * 2048, 0, r & 511, nullptr); } r -= 1024;
    if (r < TG) return tile_make(pp->w_gate, 2048, 5632, (bf16_t*)(ws + O_WGU), 1, r, pp->ffn_norm); r -= TG;
    if (r < TG) return tile_make(pp->w_up, 2048, 5632, (bf16_t*)(ws + O_WGU), 2, r, pp->ffn_norm); r -= TG;
    if (r < TG) return tile_make(pp->w_up + (size_t)2048 * 5632, 2048, 5632, (bf16_t*)(ws + O_WGU) + (size_t)11264 * 2048, 2, r, pp->ffn_norm + DM); r -= TG;
    if (r < TG) return tile_make(pp->w_gate + (size_t)2048 * 5632, 2048, 5632, (bf16_t*)(ws + O_WGU) + (size_t)11264 * 2048, 1, r, pp->ffn_norm + DM); r -= TG;
    if (r < 1792) return tile_make(pp->sgu_w_in, 2048, 3584, (bf16_t*)(ws + O_WIN1), 0, r, pp->mix_norm + DM); r -= 1792;
    if (r < 1024) return tile_make(pp->sgu_w_out, 2048, 2048, (bf16_t*)(ws + O_WOUT1), 0, r, nullptr); r -= 1024;
    if (r < TG) return tile_make(pp->w_down, 5632, 2048, (bf16_t*)(ws + O_WDN), 0, r, nullptr); r -= TG;
    return tile_make(pp->w_down + (size_t)5632 * 2048, 5632, 2048, (bf16_t*)(ws + O_WDN) + (size_t)2048 * 5632, 0, r, nullptr);
}
__device__ __forceinline__ void tile_load(const TileDesc& d, f32x4 (&v)[16], int lane) {
    const float* p = d.src + (size_t)(lane >> 4) * d.N + 4 * (lane & 15);
#pragma unroll
    for (int i = 0; i < 16; ++i) v[i] = __builtin_nontemporal_load((const f32x4*)(p + (size_t)(4 * i) * d.N));
}
__device__ __forceinline__ void tile_store(const TileDesc& d, const f32x4 (&v)[16], LAS float* scr, int lane) {
    const int r4 = lane >> 4, c4 = lane & 15;
#pragma unroll
    for (int i = 0; i < 16; ++i) {
        const float gg = d.gk ? d.gk[4 * i + r4] : 1.0f;
        LAS float* q = scr + (4 * i + r4) * 65 + 4 * c4;
        q[0] = v[i].x * gg; q[1] = v[i].y * gg; q[2] = v[i].z * gg; q[3] = v[i].w * gg;
    }
    LDS_WAIT();
    const int c = lane & 7;
#pragma unroll
    for (int j = 0; j < 8; ++j) {
        const int n = (lane >> 3) + 8 * j; const LAS float* s = scr + (8 * c) * 65 + n;
        u32x4 o; o.x = cvt_pk_bf16(s[0 * 65], s[1 * 65]); o.y = cvt_pk_bf16(s[2 * 65], s[3 * 65]); o.z = cvt_pk_bf16(s[4 * 65], s[5 * 65]); o.w = cvt_pk_bf16(s[6 * 65], s[7 * 65]);
        *(u32x4*)(d.dst + (size_t)n * d.K + 8 * c) = o;
    }
    LDS_WAIT();
}
__device__ __forceinline__ void convert_tiles(const Params __attribute__((address_space(4)))* pp, unsigned char* ws, int lo, int hi, int w0, int nw, LAS float* scr, int lane) {
    int it = lo + w0;
    if (it >= hi) return;
    TileDesc d0 = tile_decode(pp, ws, it);
    f32x4 v[16], vn[16];
    tile_load(d0, v, lane);
    for (;;) {
        const int it1 = it + nw; const bool has = it1 < hi;
        TileDesc d1 = d0;
        if (has) { d1 = tile_decode(pp, ws, it1); tile_load(d1, vn, lane); }
        tile_store(d0, v, scr, lane);
        if (!has) break;
#pragma unroll
        for (int i = 0; i < 16; ++i) v[i] = vn[i];
        d0 = d1; it = it1;
    }
}
__device__ __forceinline__ void rms_row(const float* xrow, const float* g, bf16_t* obf, float* of32, int lane) {
    const f32x4* xr = (const f32x4*)xrow + lane; const f32x4* gr = (const f32x4*)g + lane;
    f32x4 v[8]; float s = 0.f;
#pragma unroll
    for (int j = 0; j < 8; ++j) { v[j] = __builtin_nontemporal_load(xr + 64 * j); s += (v[j].x * v[j].x + v[j].y * v[j].y) + (v[j].z * v[j].z + v[j].w * v[j].w); }
    const float rstd = rsqrtf(wave_sum(s) * (1.0f / 2048.0f) + 1e-6f);
    if (obf) {
        u32x2* o8 = (u32x2*)obf + lane;
#pragma unroll
        for (int j = 0; j < 8; ++j) { const f32x4 gg = gr[64 * j]; const f32x4 o = v[j] * rstd * gg; u32x2 w; w.x = cvt_pk_bf16(o.x, o.y); w.y = cvt_pk_bf16(o.z, o.w); o8[64 * j] = w; }
    } else {
        f32x4* o16 = (f32x4*)of32 + lane;
#pragma unroll
        for (int j = 0; j < 8; ++j) { const f32x4 gg = gr[64 * j]; o16[64 * j] = v[j] * rstd * gg; }
    }
}

constexpr int KS_PITCH = 272, VT_PITCH = 528, VT_OFF = 256 * KS_PITCH;
struct HalfRegs { u32x4 k[4]; u32x4 va[2], vb[2]; };
__device__ __forceinline__ void half_fetch(HalfRegs& h, const bf16_t* kp, const bf16_t* vp, unsigned kvs, int tid) {
    const int wid = tid >> 6, lane = tid & 63;
    { const int ch = tid & 15, r0 = tid >> 4;
#pragma unroll
      for (int i = 0; i < 4; ++i) h.k[i] = *(const u32x4*)(kp + (size_t)(r0 + 32 * i) * kvs + 8 * ch); }
    { const int cl = lane & 3, pair = (lane >> 2) + 16 * (wid & 3);
      const bf16_t* v0 = vp + (size_t)(2 * pair) * kvs;
#pragma unroll
      for (int i = 0; i < 2; ++i) { const int c = cl + 4 * ((wid >> 2) + 2 * i); h.va[i] = *(const u32x4*)(v0 + 8 * c); h.vb[i] = *(const u32x4*)(v0 + kvs + 8 * c); } }
}
__device__ __forceinline__ void half_commit(const HalfRegs& h, LAS unsigned char* lds, int slot, int tid) {
    const int wid = tid >> 6, lane = tid & 63;
    LAS unsigned char* Ks = lds + slot * (128 * KS_PITCH);
    LAS unsigned char* Vt = lds + VT_OFF + slot * 256;
    { const int ch = tid & 15, r0 = tid >> 4;
#pragma unroll
      for (int i = 0; i < 4; ++i) *(LAS u32x4*)(Ks + (r0 + 32 * i) * KS_PITCH + ch * 16) = h.k[i]; }
    { const int cl = lane & 3, pair = (lane >> 2) + 16 * (wid & 3);
#pragma unroll
      for (int i = 0; i < 2; ++i) { const int c = cl + 4 * ((wid >> 2) + 2 * i); const u32x4 a = h.va[i], b = h.vb[i];
          LAS unsigned char* dst = Vt + (8 * c) * VT_PITCH + 4 * pair;
          *(LAS unsigned*)(dst + 0 * VT_PITCH) = (a.x & 0xffffu) | (b.x << 16);
          *(LAS unsigned*)(dst + 1 * VT_PITCH) = (a.x >> 16) | (b.x & 0xffff0000u);
          *(LAS unsigned*)(dst + 2 * VT_PITCH) = (a.y & 0xffffu) | (b.y << 16);
          *(LAS unsigned*)(dst + 3 * VT_PITCH) = (a.y >> 16) | (b.y & 0xffff0000u);
          *(LAS unsigned*)(dst + 4 * VT_PITCH) = (a.z & 0xffffu) | (b.z << 16);
          *(LAS unsigned*)(dst + 5 * VT_PITCH) = (a.z >> 16) | (b.z & 0xffff0000u);
          *(LAS unsigned*)(dst + 6 * VT_PITCH) = (a.w & 0xffffu) | (b.w << 16);
          *(LAS unsigned*)(dst + 7 * VT_PITCH) = (a.w >> 16) | (b.w & 0xffff0000u); } }
}
__device__ __forceinline__ void q_fetch(bf16x8 (&qf)[4], const bf16_t* qp, unsigned qs, int tid) {
    const int wid = tid >> 6, lane = tid & 63, l15 = lane & 15, quad = lane >> 4;
    const bf16_t* qrow = qp + (size_t)(16 * wid + l15) * qs + 8 * quad;
#pragma unroll
    for (int ks = 0; ks < 4; ++ks) qf[ks] = *(const bf16x8*)(qrow + 32 * ks);
}
__device__ __forceinline__ void attn_compute(LAS unsigned char* lds, const bf16x8 (&qf)[4], int p, bf16_t* op, unsigned os, float* lp, unsigned ls, bool masked, bool first, int tid) {
    const int wid = __builtin_amdgcn_readfirstlane(tid >> 6), lane = tid & 63, l15 = lane & 15, quad = lane >> 4;
    LAS unsigned char* Ks = lds;
    LAS unsigned char* Vt = lds + VT_OFF;
    f32x4 s[16];
    const int qi = 16 * wid + l15;
#pragma unroll
    for (int kt = 0; kt < 16; ++kt) {
        f32x4 a = (f32x4){0.f, 0.f, 0.f, 0.f};
        if (!masked || (kt >= wid && kt <= wid + 8 && (!first || kt >= 8))) {
            const int pt = (kt + 8 * p) & 15;
#pragma unroll
            for (int ks = 0; ks < 4; ++ks) { const bf16x8 kf = *(const LAS bf16x8*)(Ks + (16 * pt + l15) * KS_PITCH + ks * 64 + quad * 16);
                a = __builtin_amdgcn_mfma_f32_16x16x32_bf16(kf, qf[ks], a, 0, 0, 0); }
        }
        s[kt] = a;
    }
    constexpr float SC = 0.08838834764831845f * 1.4426950408889634f;
    float mx = -3.0e38f;
#pragma unroll
    for (int kt = 0; kt < 16; ++kt) {
        if (!masked || (kt >= wid && kt <= wid + 8 && (!first || kt >= 8))) {
            if (masked && (kt == wid || kt == wid + 8)) {
#pragma unroll
                for (int j = 0; j < 4; ++j) { const int key = 16 * kt + 4 * quad + j; if (!(key >= qi && key <= qi + 128)) s[kt][j] = -1.0e30f; }
            }
            mx = fmaxf(mx, fmaxf(fmaxf(s[kt][0], s[kt][1]), fmaxf(s[kt][2], s[kt][3])));
        }
    }
    mx = fmaxf(mx, __shfl_xor(mx, 16)); mx = fmaxf(mx, __shfl_xor(mx, 32));
    const float nb = -mx * SC;
    float sum = 0.f;
#pragma unroll
    for (int kt = 0; kt < 16; ++kt) {
        if (!masked || (kt >= wid && kt <= wid + 8 && (!first || kt >= 8))) {
#pragma unroll
            for (int j = 0; j < 4; ++j) { const float pp_ = __builtin_amdgcn_exp2f(fmaf(s[kt][j], SC, nb)); s[kt][j] = pp_; sum += pp_; }
        }
    }
    sum += __shfl_xor(sum, 16); sum += __shfl_xor(sum, 32);
    bf16x8 pb[8];
#pragma unroll
    for (int t = 0; t < 8; ++t) { u32x4 w; w.x = cvt_pk_bf16(s[2 * t][0], s[2 * t][1]); w.y = cvt_pk_bf16(s[2 * t][2], s[2 * t][3]);
        w.z = cvt_pk_bf16(s[2 * t + 1][0], s[2 * t + 1][1]); w.w = cvt_pk_bf16(s[2 * t + 1][2], s[2 * t + 1][3]); pb[t] = __builtin_bit_cast(bf16x8, w); }
    const float inv = 1.0f / sum;
    bf16_t* orow = op + (size_t)qi * os + 4 * quad;
#pragma unroll
    for (int dt = 0; dt < 8; ++dt) {
        f32x4 a = (f32x4){0.f, 0.f, 0.f, 0.f};
#pragma unroll
        for (int t = 0; t < 8; ++t) {
            if (!masked || (2 * t + 1 >= wid && 2 * t <= wid + 8)) {
                const int pt = (t + 4 * p) & 7;
                const LAS unsigned char* vr = Vt + (16 * dt + l15) * VT_PITCH + (32 * pt + 4 * quad) * 2;
                const u32x2 lo = *(const LAS u32x2*)vr, hi = *(const LAS u32x2*)(vr + 32);
                u32x4 w; w.x = lo.x; w.y = lo.y; w.z = hi.x; w.w = hi.y;
                a = __builtin_amdgcn_mfma_f32_16x16x32_bf16(__builtin_bit_cast(bf16x8, w), pb[t], a, 0, 0, 0);
            }
        }
        u32x2 w; w.x = cvt_pk_bf16(a[0] * inv, a[1] * inv); w.y = cvt_pk_bf16(a[2] * inv, a[3] * inv);
        *(u32x2*)(orow + 16 * dt) = w;
    }
    if (lp && quad == 0) lp[(size_t)qi * ls] = (mx * SC + __log2f(sum)) * 0.6931471805599453f;
}
__device__ __forceinline__ void attn_run(LAS unsigned char* lds, int n0, int nit, const bf16_t* qp, unsigned qbs, unsigned qs, const bf16_t* kp, const bf16_t* vp, unsigned kbs, unsigned kvs,
                                         bf16_t* op, unsigned obs, unsigned os, float* lp, unsigned lbs, unsigned ls, bool masked, int tid) {
    HalfRegs hr; bf16x8 qf[4];
    __syncthreads();
    {
        HalfRegs h2;
        if (kbs == 0) {
            half_fetch(hr, kp, vp, kvs, tid); half_fetch(h2, kp + (size_t)128 * kvs, vp + (size_t)128 * kvs, kvs, tid);
            q_fetch(qf, qp + (size_t)n0 * qbs, qs, tid);
            half_commit(hr, lds, 0, tid); half_commit(h2, lds, 1, tid);
        } else {
            const int mprev = n0 > 0 ? n0 - 1 : 0;
            half_fetch(hr, kp + (size_t)mprev * kbs, vp + (size_t)mprev * kbs, kvs, tid); half_fetch(h2, kp + (size_t)n0 * kbs, vp + (size_t)n0 * kbs, kvs, tid);
            q_fetch(qf, qp + (size_t)n0 * qbs, qs, tid);
            half_commit(hr, lds, (n0 - 1) & 1, tid); half_commit(h2, lds, n0 & 1, tid);
        }
    }
    __syncthreads();
#pragma unroll 1
    for (int j = 0; j < nit; ++j) {
        const int n = n0 + j; const bool more = j + 1 < nit;
        if (more && kbs != 0) half_fetch(hr, kp + (size_t)(n + 1) * kbs, vp + (size_t)(n + 1) * kbs, kvs, tid);
        attn_compute(lds, qf, kbs == 0 ? 0 : ((n - 1) & 1), op + (size_t)n * obs, os, lp ? lp + (size_t)n * lbs : nullptr, ls, masked, masked && n == 0, tid);
        if (more) {
            __syncthreads();
            q_fetch(qf, qp + (size_t)(n + 1) * qbs, qs, tid);
            if (kbs != 0) half_commit(hr, lds, (n + 1) & 1, tid);
            __syncthreads();
        }
    }
}

__device__ __forceinline__ void sgu_item(LAS unsigned char* lds, const bf16_t* proj, const u64* stats, const float* lng, const float* lnb,
                                         const bf16_t* wsp, const float* bsp, bf16_t* cat, int n, int g, int tid) {
    const int wid = __builtin_amdgcn_readfirstlane(tid >> 6), lane = tid & 63, l15 = lane & 15, quad = lane >> 4;
    LAS unsigned char* Vt = lds + VT_OFF;
    __syncthreads();
    bf16x8 wf[4];
    { const bf16_t* wrow = wsp + (size_t)g * 16384 + (size_t)(16 * wid + l15) * 128 + 8 * quad;
#pragma unroll
      for (int ks = 0; ks < 4; ++ks) wf[ks] = *(const bf16x8*)(wrow + 32 * ks); }
    { const int cl = lane & 3, pair = (lane >> 2) + 16 * (wid & 3);
      const int row0 = 128 * n + 2 * pair;
      const f32x2 st0 = (f32x2){fs_get(stats + 2 * row0), fs_get(stats + 2 * row0 + 1)}, st1 = (f32x2){fs_get(stats + 2 * row0 + 2), fs_get(stats + 2 * row0 + 3)};
      const float mu0 = st0.x * (1.0f / 1536.0f), mu1 = st1.x * (1.0f / 1536.0f);
      const float rs0 = rsqrtf(fmaxf(st0.y * (1.0f / 1536.0f) - mu0 * mu0, 0.f) + 1e-5f), rs1 = rsqrtf(fmaxf(st1.y * (1.0f / 1536.0f) - mu1 * mu1, 0.f) + 1e-5f);
      const bf16_t* v0 = proj + (size_t)row0 * NIN1 + 1536 + 128 * g;
#pragma unroll
      for (int i = 0; i < 2; ++i) { const int c = cl + 4 * ((wid >> 2) + 2 * i);
          const u32x4 a = *(const u32x4*)(v0 + 8 * c), b = *(const u32x4*)(v0 + NIN1 + 8 * c);
          const f32x4 g0 = *(const f32x4*)(lng + 128 * g + 8 * c), g1 = *(const f32x4*)(lng + 128 * g + 8 * c + 4);
          const f32x4 b0 = *(const f32x4*)(lnb + 128 * g + 8 * c), b1 = *(const f32x4*)(lnb + 128 * g + 8 * c + 4);
          const unsigned aw[4] = {a.x, a.y, a.z, a.w}, bw[4] = {b.x, b.y, b.z, b.w};
          const float gg[8] = {g0.x, g0.y, g0.z, g0.w, g1.x, g1.y, g1.z, g1.w}, bb[8] = {b0.x, b0.y, b0.z, b0.w, b1.x, b1.y, b1.z, b1.w};
          LAS unsigned char* dst = Vt + (8 * c) * VT_PITCH + 4 * pair;
#pragma unroll
          for (int e = 0; e < 8; ++e) {
              const float xa = (e & 1) ? bf_hi(aw[e >> 1]) : bf_lo(aw[e >> 1]);
              const float xb = (e & 1) ? bf_hi(bw[e >> 1]) : bf_lo(bw[e >> 1]);
              const float ya = (xa - mu0) * rs0 * gg[e] + bb[e], yb = (xb - mu1) * rs1 * gg[e] + bb[e];
              *(LAS unsigned*)(dst + e * VT_PITCH) = cvt_pk_bf16(ya, yb);
          } } }
    __syncthreads();
    const int t = 16 * wid + l15;
    const float bias = bsp[g * 128 + t];
    const size_t grow = (size_t)(128 * n + t);
    const bf16_t* urow = proj + grow * NIN1 + 128 * g + 4 * quad;
    bf16_t* orow = cat + grow * 2048 + 128 * g + 4 * quad;
#pragma unroll
    for (int ct = 0; ct < 8; ++ct) {
        f32x4 a = (f32x4){0.f, 0.f, 0.f, 0.f};
#pragma unroll
        for (int ks = 0; ks < 4; ++ks) {
            if (32 * ks <= 16 * wid + 15) {
                const bf16x8 vf = *(const LAS bf16x8*)(Vt + (16 * ct + l15) * VT_PITCH + ks * 64 + quad * 16);
                a = __builtin_amdgcn_mfma_f32_16x16x32_bf16(vf, wf[ks], a, 0, 0, 0);
            }
        }
        const u32x2 uu = *(const u32x2*)(urow + 16 * ct);
        u32x2 w; w.x = cvt_pk_bf16((a[0] + bias) * bf_lo(uu.x), (a[1] + bias) * bf_hi(uu.x)); w.y = cvt_pk_bf16((a[2] + bias) * bf_lo(uu.y), (a[3] + bias) * bf_hi(uu.y));
        *(u32x2*)(orow + 16 * ct) = w;
    }
}

#define XB_TMO      128
#define XB_XCNT(j)  (256  + 64 * (j))
#define XB_XSUB(j)  (1280 + 64 * (j))
#define XB_XGEN(j)  (2304 + 64 * (j))
#define XB_TOP      3328
#define XB_TOPGEN   3392
#define XCD_BAR_WORDS 3456
#define XB_SPIN_CAP (1u << 18)
__device__ __forceinline__ unsigned xb_ld(unsigned* p)              { return __hip_atomic_load(p, __ATOMIC_RELAXED, __HIP_MEMORY_SCOPE_AGENT); }
__device__ __forceinline__ unsigned xb_add(unsigned* p, unsigned v) { return __hip_atomic_fetch_add(p, v, __ATOMIC_RELAXED, __HIP_MEMORY_SCOPE_AGENT); }
__device__ __forceinline__ unsigned xb_xcc_id() { return (unsigned)__builtin_amdgcn_s_getreg((3 << 11) | 20) & 0xFu; }
#define XB_SPIN(cond, bar) do { unsigned _sp = 0; while (cond) { __builtin_amdgcn_s_sleep(1); \
    if ((++_sp & 255u) == 0u) { if (xb_ld(&(bar)[XB_TMO])) break; if (_sp > XB_SPIN_CAP) { atomicAdd(&(bar)[XB_TMO], 1u); break; } } } } while (0)
struct XcdBarrier { unsigned* bar; unsigned x; volatile LAS unsigned* st; };
__device__ __forceinline__ XcdBarrier xcd_barrier_post(unsigned* bar, volatile LAS unsigned* st) {
    XcdBarrier b; b.bar = bar; b.x = xb_xcc_id(); b.st = st;
    if (threadIdx.x == 0) (void)xb_add(&bar[XB_XCNT(b.x)], 1u);
    return b;
}
__device__ __forceinline__ void xcd_barrier_complete(unsigned* bar, unsigned x, unsigned& nloc, unsigned& nx) {
    const unsigned G = gridDim.x * gridDim.y * gridDim.z;
    unsigned sum, cnt, mine, sp = 0u;
    for (;;) {
        sum = 0u; cnt = 0u; mine = 0u;
#pragma unroll
        for (unsigned j = 0; j < 16; ++j) { const unsigned c = xb_ld(&bar[XB_XCNT(j)]); sum += c; cnt += (c > 0u) ? 1u : 0u; mine = (j == x) ? c : mine; }
        if (sum == G) break;
        __builtin_amdgcn_s_sleep(1);
        if ((++sp & 255u) == 0u) { if (xb_ld(&bar[XB_TMO])) break; if (sp > XB_SPIN_CAP) { atomicAdd(&bar[XB_TMO], 1u); break; } }
    }
    nloc = mine > 0u ? mine : 1u; nx = cnt > 0u ? cnt : 1u;
}
__device__ __forceinline__ void xcd_barrier(const XcdBarrier& b) {
    asm volatile("s_waitcnt vmcnt(0)" ::: "memory");
    __syncthreads();
    if (threadIdx.x == 0) {
        unsigned* bar = b.bar;
        __builtin_amdgcn_s_waitcnt(0);
        unsigned nloc = b.st[0], nx = b.st[1];
        if (nloc == 0u) { xcd_barrier_complete(bar, b.x, nloc, nx); b.st[0] = nloc; b.st[1] = nx; }
        const unsigned old = xb_add(&bar[XB_XSUB(b.x)], 1u);
        const unsigned gen = old / nloc;
        if (old + 1u == (gen + 1u) * nloc) {
            __builtin_amdgcn_fence(__ATOMIC_RELEASE, "agent");
            asm volatile("s_waitcnt vmcnt(0)" ::: "memory");
            const unsigned og = xb_add(&bar[XB_TOP], 1u);
            const unsigned tg = og / nx;
            if (og + 1u == (tg + 1u) * nx) xb_add(&bar[XB_TOPGEN], 1u);
            else XB_SPIN(xb_ld(&bar[XB_TOPGEN]) == tg, bar);
            __builtin_amdgcn_fence(__ATOMIC_ACQUIRE, "agent");
            xb_add(&bar[XB_XGEN(b.x)], 1u);
            asm volatile("s_waitcnt vmcnt(0)" ::: "memory");
        } else {
            XB_SPIN(xb_ld(&bar[XB_XGEN(b.x)]) == gen, bar);
            __builtin_amdgcn_fence(__ATOMIC_ACQUIRE, "agent");
            asm volatile("s_waitcnt vmcnt(0)" ::: "memory");
        }
    }
    __syncthreads();
}

enum { K_PREP = 0, K_GEMM_BF = 1, K_MIX = 2, K_MERGE = 3, K_GEMM_RES = 4, K_NORM = 5, K_GEMM_GU = 6 };
constexpr unsigned long long KINDS = 0x0ull | (1ull << 4) | (2ull << 8) | (3ull << 12) | (4ull << 16) | (6ull << 20) | (4ull << 24) | (1ull << 28) | (2ull << 32) | (4ull << 36) |
                                     (6ull << 40) | (4ull << 44) | (5ull << 48);
constexpr int NSTEPS = 13;
#ifndef ENMASK
#define ENMASK 0x7f
#endif
#ifndef REP_MASK
#define REP_MASK 0
#endif
#ifndef SYNC_REP
#define SYNC_REP 1
#endif

__global__ void __launch_bounds__(512, 2) fwd_megakernel(Params p) {
    extern __shared__ __attribute__((aligned(16))) unsigned char lds_raw[];
    LAS unsigned char* lds = (LAS unsigned char*)lds_raw;
    cg::grid_group grid = cg::this_grid();
    const int G = gridDim.x, bid = blockIdx.x;
    if (threadIdx.x < 4) ((LAS unsigned*)(lds + LDS_CTL))[threadIdx.x] = 0u;
    __syncthreads();
    if (p.ws == nullptr) grid.sync();
    const XcdBarrier xbar = xcd_barrier_post((unsigned*)(p.ws + O_BAR), (volatile LAS unsigned*)(lds + LDS_CTL));
#pragma unroll 1
    for (int step = 0; step < NSTEPS; ++step) {
        const int kind = (int)((KINDS >> (4 * step)) & 15ull);
        const int layer = (step >= 7) ? 1 : 0;
        const bool idem = (kind == K_PREP) || (kind == K_MIX) || (kind == K_MERGE) || (kind == K_NORM) || (kind == K_GEMM_GU) || (kind == K_GEMM_BF && layer == 0);
        const int nrep = (REP_MASK != 0 && ((REP_MASK >> kind) & 1) && idem) ? 2 : 1;
#pragma unroll 1
        for (int rep = 0; rep < nrep; ++rep) {
        int tid = threadIdx.x; asm volatile("" : "+v"(tid));
        const Params __attribute__((address_space(4)))* pp = (const Params __attribute__((address_space(4)))*)__builtin_amdgcn_kernarg_segment_ptr();
        asm volatile("" : "+s"(pp));
        unsigned char* ws = pp->ws;
        const int lane = tid & 63, wave = __builtin_amdgcn_readfirstlane(tid >> 6);
        bf16_t* WIN0 = (bf16_t*)(ws + O_WIN0); bf16_t* WOUT0 = (bf16_t*)(ws + O_WOUT0); bf16_t* WIN1 = (bf16_t*)(ws + O_WIN1); bf16_t* WOUT1 = (bf16_t*)(ws + O_WOUT1);
        bf16_t* WGU = (bf16_t*)(ws + O_WGU); bf16_t* WDN = (bf16_t*)(ws + O_WDN); bf16_t* WKV = (bf16_t*)(ws + O_WKV); bf16_t* WSP = (bf16_t*)(ws + O_WSP);
        bf16_t* H = (bf16_t*)(ws + O_H); bf16_t* AO = (bf16_t*)(ws + O_H); bf16_t* BIG = (bf16_t*)(ws + O_BIG); bf16_t* CAT = (bf16_t*)(ws + O_CAT);
        float* LSE = (float*)(ws + O_LSE); bf16_t* MEMN = (bf16_t*)(ws + O_MEMN); bf16_t* MEMKV = (bf16_t*)(ws + O_MEMKV); float* ROPE = (float*)(ws + O_ROPE); u64* STATS = (u64*)(ws + O_STATS); u64* SS = (u64*)(ws + O_SS);

        int cv_lo = 0, cv_hi = 0, cv_w0 = 0, cv_nw = 1;
        switch (kind) {
        case K_PREP: if constexpr ((ENMASK >> 0) & 1) {
            const int gw = bid * 8 + wave, NGW = G * 8;
            cv_lo = 0; cv_hi = CV_PREP; cv_w0 = gw; cv_nw = NGW;
            for (int m = gw; m < SEQ + 512; m += NGW) {
                if (m < SEQ) rms_row(pp->x + (size_t)m * DM, pp->mix_norm, H + (size_t)m * DM, nullptr, lane);
                else { const int mm = m - SEQ, l = mm >> 8, r = mm & 255; rms_row(pp->mem + (size_t)r * DM, pp->mem_norm + l * DM, MEMN + (size_t)mm * DM, nullptr, lane); }
            }
            const int gt = bid * 512 + tid, NGT = G * 512;
            for (int i = gt; i < SEQ * 16; i += NGT) {
                const int t = i >> 4, f = i & 15;
                const float inv = exp2f(-(float)f * 1.1832230355827609f);
                const float ang = (float)pp->pos[t] * inv;
                const float k = rintf(ang * 0.15915494309189535f);
                float r = fmaf(-k, 6.28125f, ang); r = fmaf(-k, 0.0019353071795864769f, r);
                ROPE[2 * i] = __cosf(r); ROPE[2 * i + 1] = __sinf(r);
            }
            for (int i = gt; i < SEQ * 6; i += NGT) STATS[i] = 0u;
            for (int i = gt; i < 12 * 128 * 128; i += NGT) { const int tt = (i >> 7) & 127, ss = i & 127; const float w = (ss <= tt) ? pp->sgu_w_spatial[i] : 0.f; WSP[i] = (bf16_t)(cvt_pk_bf16(w, 0.f) & 0xffffu); }
        } break;
        case K_GEMM_BF: if constexpr ((ENMASK >> 1) & 1) {
            const int nsub = layer ? 1 : 2;
#pragma unroll 1
            for (int sub = 0; sub < nsub; ++sub) {
                pg8::Gemm g; pg8::Order S; pg8::EpiBf E;
                if (layer == 0 && sub == 0) { g = pg8::Gemm{H, WIN0, SEQ, NIN0, DM}; S.init(SEQ, NIN0, G, bid, 0); E = pg8::EpiBf{BIG, NIN0, 12, 0, 0, 0, ROPE, STATS, nullptr}; }
                else if (layer == 0) { g = pg8::Gemm{MEMN, WKV, 512, 2048, DM}; S.init(512, 2048, G, bid, 1); E = pg8::EpiBf{MEMKV, 2048, 0, 0, 0, 0, ROPE, STATS, nullptr}; }
                else { g = pg8::Gemm{H, WIN1, SEQ, NIN1, DM}; S.init(SEQ, NIN1, G, bid, 0); E = pg8::EpiBf{BIG, NIN1, 0, 12, 6, 12, ROPE, STATS, SS + SEQ}; }
                pg8::gemm_phase<pg8::EpiBf>(lds, g, S, E);
            }
            if (rep == 0) {
                if (layer == 0) { if (bid >= 136) { cv_lo = CV_S5; cv_hi = CV_S1; cv_w0 = (bid - 136) * 8 + wave; cv_nw = (G - 136) * 8; } }
                else { if (bid >= 192) { cv_lo = CV_PREP; cv_hi = CV_S7; cv_w0 = (bid - 192) * 8 + wave; cv_nw = (G - 192) * 8; } }
            }
        } break;
        case K_MIX: if constexpr ((ENMASK >> 2) & 1) {
            if (layer == 0) {
                if (bid < 192) {
                    const int g = bid >> 6, rr = bid & 63, h = rr & 3, chain = rr >> 2;
                    const int d = (g == 0) ? 1 : ((g == 1) ? 4 : 16), rpr = 16 / d, r = chain / rpr, n0 = 4 * (chain - r * rpr);
                    const bf16_t* base = BIG + (size_t)r * NIN0 + (4 * g + h) * 128;
                    attn_run(lds, n0, 4, base, 128u * d * NIN0, (unsigned)d * NIN0, base + 1536, base + 3072, 128u * d * NIN0, (unsigned)d * NIN0,
                             AO + (size_t)g * SEQ * 512 + (size_t)r * 512 + h * 128, 128u * d * 512, (unsigned)d * 512,
                             LSE + (size_t)g * SEQ * 4 + (size_t)r * 4 + h, 128u * d * 4, (unsigned)d * 4, true, tid);
                } else {
                    const int mb = bid - 192, h = mb & 3, n0 = 4 * (mb >> 2);
                    const bf16_t* kv = MEMKV + h * 128;
                    attn_run(lds, n0, 4, BIG + 4608 + h * 128, 128u * NIN0, (unsigned)NIN0, kv, kv + 512, 0u, 2048u,
                             CAT + 512 + h * 128, 128u * 1024, 1024u, nullptr, 0u, 0u, false, tid);
                }
            } else {
#pragma unroll 1
                for (int it = bid; it < 1024; it += G) {
                    if (it >= 768) {
                        const int rem = it - 768, h = rem & 3, n = rem >> 2;
                        const bf16_t* kv = MEMKV + (size_t)256 * 2048 + 1024 + h * 128;
                        attn_run(lds, n, 1, BIG + 3072 + h * 128, 128u * NIN1, (unsigned)NIN1, kv, kv + 512, 0u, 2048u,
                                 CAT + 1536 + h * 128, 128u * 2048, 2048u, nullptr, 0u, 0u, false, tid);
                    } else {
                        const int g = it % 12, n = it / 12;
                        sgu_item(lds, BIG, STATS, pp->sgu_ln_g, pp->sgu_ln_b, WSP, pp->sgu_b_spatial, CAT, n, g, tid);
                    }
                }
            }
        } break;
        case K_MERGE: if constexpr ((ENMASK >> 3) & 1) {
            const int gt = bid * 512 + tid, NGT = G * 512;
#pragma unroll 1
            for (int i0 = gt; i0 < SEQ * 64; i0 += 4 * NGT) {
                float l0[4], l1[4], l2[4]; u32x4 a[4], b[4], c[4];
#pragma unroll
                for (int j = 0; j < 4; ++j) {
                    const int i = (i0 + j * NGT < SEQ * 64) ? i0 + j * NGT : i0;
                    const int t = i >> 6, rem = i & 63, h = rem >> 4, c8 = rem & 15;
                    l0[j] = LSE[(size_t)t * 4 + h]; l1[j] = LSE[(size_t)SEQ * 4 + t * 4 + h]; l2[j] = LSE[(size_t)2 * SEQ * 4 + t * 4 + h];
                    const size_t off = (size_t)t * 512 + h * 128 + c8 * 8;
                    a[j] = *(const u32x4*)(AO + off); b[j] = *(const u32x4*)(AO + (size_t)SEQ * 512 + off); c[j] = *(const u32x4*)(AO + (size_t)2 * SEQ * 512 + off);
                }
#pragma unroll
                for (int j = 0; j < 4; ++j) {
                    const int i = i0 + j * NGT;
                    if (i < SEQ * 64) {
                        const int t = i >> 6, rem = i & 63, h = rem >> 4, c8 = rem & 15;
                        const float m = fmaxf(l0[j], fmaxf(l1[j], l2[j]));
                        float w0 = __expf(l0[j] - m), w1 = __expf(l1[j] - m), w2 = __expf(l2[j] - m);
                        const float inv = 1.0f / (w0 + w1 + w2); w0 *= inv; w1 *= inv; w2 *= inv;
                        const u32x4 aa = a[j], bb = b[j], cc = c[j];
                        u32x4 o;
                        o.x = cvt_pk_bf16(w0 * bf_lo(aa.x) + w1 * bf_lo(bb.x) + w2 * bf_lo(cc.x), w0 * bf_hi(aa.x) + w1 * bf_hi(bb.x) + w2 * bf_hi(cc.x));
                        o.y = cvt_pk_bf16(w0 * bf_lo(aa.y) + w1 * bf_lo(bb.y) + w2 * bf_lo(cc.y), w0 * bf_hi(aa.y) + w1 * bf_hi(bb.y) + w2 * bf_hi(cc.y));
                        o.z = cvt_pk_bf16(w0 * bf_lo(aa.z) + w1 * bf_lo(bb.z) + w2 * bf_lo(cc.z), w0 * bf_hi(aa.z) + w1 * bf_hi(bb.z) + w2 * bf_hi(cc.z));
                        o.w = cvt_pk_bf16(w0 * bf_lo(aa.w) + w1 * bf_lo(bb.w) + w2 * bf_lo(cc.w), w0 * bf_hi(aa.w) + w1 * bf_hi(bb.w) + w2 * bf_hi(cc.w));
                        *(u32x4*)(CAT + (size_t)t * 1024 + h * 128 + c8 * 8) = o;
                    }
                }
            }
        } break;
        case K_GEMM_RES: if constexpr ((ENMASK >> 4) & 1) {
            pg8::Gemm g; pg8::EpiRes E{nullptr, H, SS};
            if (step == 4) { g = pg8::Gemm{CAT, WOUT0, SEQ, DM, 1024}; E.base32 = pp->x; }
            else if (step == 6) { g = pg8::Gemm{BIG, WDN, SEQ, DM, FF}; E.ss = SS + SEQ; }
            else if (step == 9) { g = pg8::Gemm{CAT, WOUT1, SEQ, DM, 2048}; E.ss = SS + 2 * SEQ; }
            else { g = pg8::Gemm{BIG, WDN + (size_t)2048 * 5632, SEQ, DM, FF}; E.ss = SS + 3 * SEQ; }
            pg8::Order S; S.init(SEQ, DM, G, bid, 0);
            pg8::gemm_phase<pg8::EpiRes>(lds, g, S, E);
        } break;
        case K_NORM: if constexpr ((ENMASK >> 5) & 1) {
            const int gw = bid * 8 + wave, NGW = G * 8;
            for (int m = gw; m < SEQ; m += NGW) {
                const float rstd = rsqrtf(fx_get(SS + 3 * SEQ + m) * (1.0f / 2048.0f) + 1e-6f);
                const u32x4* xr = (const u32x4*)(H + (size_t)m * DM) + lane; const f32x4* gr = (const f32x4*)pp->final_norm + 2 * lane; f32x4* orow = (f32x4*)(pp->out + (size_t)m * DM) + 2 * lane;
#pragma unroll
                for (int j = 0; j < 4; ++j) { const u32x4 w = __builtin_nontemporal_load(xr + 64 * j); const f32x4 g0 = gr[128 * j], g1 = gr[128 * j + 1];
                    __builtin_nontemporal_store((f32x4){bf_lo(w.x), bf_hi(w.x), bf_lo(w.y), bf_hi(w.y)} * rstd * g0, orow + 128 * j); __builtin_nontemporal_store((f32x4){bf_lo(w.z), bf_hi(w.z), bf_lo(w.w), bf_hi(w.w)} * rstd * g1, orow + 128 * j + 1); }
            }
        } break;
        case K_GEMM_GU: if constexpr ((ENMASK >> 6) & 1) {
            pg8::Gemm g{H, WGU + (size_t)layer * 11264 * 2048, SEQ, 11264, DM};
            pg8::Order S; S.init(SEQ, 11264, G, bid, 0);
            pg8::EpiGU E{BIG, SS + (layer ? 2 * SEQ : 0)};
            pg8::gemm_phase<pg8::EpiGU>(lds, g, S, E);
            if (rep == 0 && bid >= 128) {
                if (layer == 0) { cv_lo = CV_S7; cv_hi = CV_S5; } else { cv_lo = CV_S1; cv_hi = CV_END; }
                cv_w0 = (bid - 128) * 8 + wave; cv_nw = (G - 128) * 8;
            }
        } break;
        default: break;
        }
        if (cv_hi > cv_lo) convert_tiles(pp, ws, cv_lo, cv_hi, cv_w0, cv_nw, (LAS float*)(lds + wave * 16640), lane);
        if (step + 1 < NSTEPS || rep + 1 < nrep) {
#pragma unroll 1
            for (int sr = 0; sr < SYNC_REP; ++sr) xcd_barrier(xbar);
        }
        }
    }
}

extern "C" void kernel_launch(void* const* d_in, const int* in_sizes, int n_in, void* d_out, int out_size, void* d_ws, size_t ws_size, hipStream_t stream) {
    static int grid_blocks = 0;
    if (grid_blocks == 0) {
        if (n_in != 19 || ws_size < WS_NEED || out_size != SEQ * DM) { fprintf(stderr, "kernel_launch: unexpected problem (n_in %d, ws %zu need %zu, out %d)\n", n_in, ws_size, (size_t)WS_NEED, out_size); grid_blocks = -1; return; }
        int dev = 0, cus = 0, per_cu = 0;
        (void)hipGetDevice(&dev);
        (void)hipDeviceGetAttribute(&cus, hipDeviceAttributeMultiprocessorCount, dev);
        if (hipFuncSetAttribute((const void*)fwd_megakernel, hipFuncAttributeMaxDynamicSharedMemorySize, LDS_BYTES) != hipSuccess) { fprintf(stderr, "kernel_launch: hipFuncSetAttribute failed\n"); grid_blocks = -1; return; }
        if (hipOccupancyMaxActiveBlocksPerMultiprocessor(&per_cu, (const void*)fwd_megakernel, 512, LDS_BYTES) != hipSuccess || per_cu < 1) { fprintf(stderr, "kernel_launch: occupancy query failed (%d)\n", per_cu); grid_blocks = -1; return; }
        grid_blocks = cus * 1;
    }
    if (grid_blocks < 0) return;
    Params p{};
    p.x = (const float*)d_in[0]; p.mem = (const float*)d_in[1]; p.pos = (const int*)d_in[2];
    p.mix_norm = (const float*)d_in[3]; p.mem_norm = (const float*)d_in[4]; p.w_mem_kv = (const float*)d_in[5]; p.ffn_norm = (const float*)d_in[6];
    p.w_gate = (const float*)d_in[7]; p.w_up = (const float*)d_in[8]; p.w_down = (const float*)d_in[9];
    p.attn_w_in = (const float*)d_in[10]; p.attn_w_out = (const float*)d_in[11]; p.sgu_w_in = (const float*)d_in[12]; p.sgu_ln_g = (const float*)d_in[13]; p.sgu_ln_b = (const float*)d_in[14];
    p.sgu_w_spatial = (const float*)d_in[15]; p.sgu_b_spatial = (const float*)d_in[16]; p.sgu_w_out = (const float*)d_in[17]; p.final_norm = (const float*)d_in[18];
    p.out = (float*)d_out; p.ws = (unsigned char*)d_ws;
    if (hipMemsetAsync(d_ws, 0, BAR_BYTES, stream) != hipSuccess) { fprintf(stderr, "kernel_launch: memset failed\n"); return; }
    void* args[] = {&p};
    hipError_t e = hipLaunchCooperativeKernel((const void*)fwd_megakernel, dim3(grid_blocks), dim3(512), args, LDS_BYTES, stream);
    if (e != hipSuccess) fprintf(stderr, "kernel_launch: cooperative launch failed: %s (grid %d)\n", hipGetErrorString(e), grid_blocks);
}
```

```cpp
#include <hip/hip_runtime.h>
#include <hip/hip_cooperative_groups.h>
#include <cstdio>
#include <cstddef>
namespace cg = cooperative_groups;

#define LAS __attribute__((address_space(3)))
typedef unsigned short bf16_t;
typedef short bf16x8 __attribute__((ext_vector_type(8)));
typedef short bf16x4 __attribute__((ext_vector_type(4)));
typedef float f32x4 __attribute__((ext_vector_type(4)));
typedef float f32x2 __attribute__((ext_vector_type(2)));
typedef unsigned u32x4 __attribute__((ext_vector_type(4)));
typedef unsigned u32x2 __attribute__((ext_vector_type(2)));

constexpr int SEQ = 8192, DM = 2048, FF = 5632;
constexpr int NIN0 = 5120, NIN1 = 3584;
constexpr int LDS_CTL = 140288;
constexpr int LDS_BYTES = LDS_CTL + 16;

constexpr size_t O_BAR = 0;
constexpr size_t BAR_BYTES = 16384;
constexpr size_t O_WIN0 = O_BAR + BAR_BYTES;
constexpr size_t O_WOUT0 = O_WIN0 + (size_t)5120 * 2048 * 2;
constexpr size_t O_WIN1 = O_WOUT0 + (size_t)2048 * 1024 * 2;
constexpr size_t O_WOUT1 = O_WIN1 + (size_t)3584 * 2048 * 2;
constexpr size_t O_WGU = O_WOUT1 + (size_t)2048 * 2048 * 2;
constexpr size_t O_WDN = O_WGU + (size_t)2 * 11264 * 2048 * 2;
constexpr size_t O_WKV = O_WDN + (size_t)2 * 2048 * 5632 * 2;
constexpr size_t O_WSP = O_WKV + (size_t)2 * 1024 * 2048 * 2;
constexpr size_t O_H = O_WSP + (size_t)12 * 128 * 128 * 2;
constexpr size_t O_BIG = O_H + (size_t)8192 * 2048 * 2;
constexpr size_t O_CAT = O_BIG + (size_t)8192 * 5632 * 2;
constexpr size_t O_LSE = O_CAT + (size_t)8192 * 2048 * 2;
constexpr size_t O_MEMN = O_LSE + (size_t)3 * 8192 * 4 * 4;
constexpr size_t O_MEMKV = O_MEMN + (size_t)512 * 2048 * 2;
constexpr size_t O_ROPE = O_MEMKV + (size_t)512 * 2048 * 2;
constexpr size_t O_STATS = O_ROPE + (size_t)8192 * 16 * 2 * 4;
constexpr size_t O_SS = O_STATS + (size_t)8192 * 2 * 4;
constexpr size_t WS_NEED = O_SS + (size_t)4 * 8192 * 4;
static_assert(WS_NEED < 459000000ull, "workspace map too large");

struct Params {
    const float* x; const float* mem; const int* pos;
    const float* mix_norm; const float* mem_norm; const float* w_mem_kv; const float* ffn_norm;
    const float* w_gate; const float* w_up; const float* w_down;
    const float* attn_w_in; const float* attn_w_out; const float* sgu_w_in; const float* sgu_ln_g; const float* sgu_ln_b;
    const float* sgu_w_spatial; const float* sgu_b_spatial; const float* sgu_w_out; const float* final_norm;
    float* out; unsigned char* ws;
};

#define LDS_WAIT() asm volatile("s_waitcnt lgkmcnt(0)" ::: "memory")
__device__ __forceinline__ unsigned cvt_pk_bf16(float lo, float hi) { unsigned r; asm volatile("v_cvt_pk_bf16_f32 %0, %1, %2" : "=v"(r) : "v"(lo), "v"(hi)); return r; }
__device__ __forceinline__ float bf_lo(unsigned w) { return __uint_as_float(w << 16); }
__device__ __forceinline__ float bf_hi(unsigned w) { return __uint_as_float(w & 0xffff0000u); }
typedef unsigned u64;
__device__ __forceinline__ void fx_add(u64* p, float v) { atomicAdd(p, __float2uint_rn(v * 16384.0f)); }
__device__ __forceinline__ float fx_get(const u64* p) { return (float)(*p) * (1.0f / 16384.0f); }
__device__ __forceinline__ void fs_add(u64* p, float v) { atomicAdd((int*)p, __float2int_rn(v * 65536.0f)); }
__device__ __forceinline__ float fs_get(const u64* p) { return (float)(*(const int*)p) * (1.0f / 65536.0f); }
__device__ __forceinline__ float wave_sum(float v) {
#pragma unroll
    for (int o = 1; o < 64; o <<= 1) v += __shfl_xor(v, o);
    return v;
}
__device__ __forceinline__ float gelu_tanh(float x) {
    const float z2 = 1.5957691216057308f * (x + 0.044715f * x * x * x);
    return x * __builtin_amdgcn_rcpf(1.0f + __expf(-z2));
}
__device__ __forceinline__ float silu(float x) { return x * __builtin_amdgcn_rcpf(1.0f + __expf(-x)); }

namespace pg8 {
constexpr int BM = 256, BK = 64, HALF = 128, HTB = HALF * BK * 2, STAGE_BYTES = 8 * HTB, NXCD = 8, WGM = 4;
__device__ __forceinline__ int lds_byte(int r, int c) { const int st = (r >> 4) * 2 + (c >> 5), rr = r & 15, cc = c & 31, ob = rr * 64 + cc * 2; return st * 1024 + (ob ^ (((ob >> 9) & 1) << 5)); }
__device__ __forceinline__ void stage_rc(int b, int& R, int& C) { const int st = b / 1024, sb = b % 1024, swz = sb ^ (((sb >> 9) & 1) << 5); R = (st >> 1) * 16 + swz / 64; C = (st & 1) * 32 + (swz % 64) / 2; }
__device__ __forceinline__ int perm32(int rho) { const int n = rho >> 4, i = rho & 15; return 8 * (i >> 2) + 4 * n + (i & 3); }

struct Unit { int pm, pn; };
struct Gemm { const bf16_t* A; const bf16_t* Bt; int M, N, K; };
struct Order {
    int nM, nN, nwg, G, c, mode;
    __device__ void init(int M, int N, int G_, int c_, int mode_) { nM = M / BM; nN = N / BM; nwg = nM * nN; G = G_; c = c_; mode = mode_; }
    __device__ bool next(int i, Unit& u) const {
        if (mode == 1) { if (i != 0 || c < 128 || c >= 136) return false; u.pm = (c - 128) >> 2; u.pn = ((c - 128) & 3) + 4 * u.pm; return true; }
        const long L = (long)i * G + c; if (L >= nwg) return false;
        int wgid = (int)L; { const int q = nwg / NXCD, r = nwg % NXCD, xcd = wgid % NXCD, off = wgid / NXCD; wgid = (xcd < r ? xcd * (q + 1) : r * (q + 1) + (xcd - r) * q) + off; }
        const int nig = WGM * nN, gid = wgid / nig, fm = gid * WGM, gsz = (nM - fm) < WGM ? (nM - fm) : WGM;
        u.pm = fm + ((wgid % nig) % gsz); u.pn = (wgid % nig) / gsz; return true;
    }
};

struct EpiBf {
    static constexpr bool PERM = true;
    bf16_t* O; int ldc; int n_rot, n_gelu, st_lo, st_hi; const float* rope; u64* stats; const u64* ss;
    __device__ __forceinline__ void operator()(const f32x4 (&acc)[2][2][4][2], const Unit& u, int wr, int wc, int fr, int fq) const {
        const int row0 = u.pm * BM + wr * 64 + fr, col0 = u.pn * BM + wc * 32 + 8 * fq;
        const bool rot = (u.pn < n_rot) && (wc == 0), gel = u.pn < n_gelu, st = (u.pn >= st_lo) && (u.pn < st_hi);
        const float sgn = (fq < 2) ? -1.0f : 1.0f;
        float rstd[8];
#pragma unroll
        for (int i = 0; i < 8; ++i) rstd[i] = ss ? fx_get(ss + row0 + (i >> 2) * HALF + (i & 3) * 16) : 0.f;
#pragma unroll
        for (int i = 0; i < 8; ++i) rstd[i] = ss ? rsqrtf(rstd[i] * (1.0f / 2048.0f) + 1e-6f) : 1.0f;
#pragma unroll
        for (int ai = 0; ai < 2; ++ai)
#pragma unroll
            for (int m = 0; m < 4; ++m) {
                const int i = ai * 4 + m, row = row0 + ai * HALF + m * 16;
                f32x4 cs[4];
                if (rot) {
                    const f32x4* rp = (const f32x4*)(rope + (size_t)row * 32 + 16 * (fq & 1));
#pragma unroll
                    for (int q = 0; q < 4; ++q) cs[q] = rp[q];
                }
                float rs = 0.f, rq = 0.f;
#pragma unroll
                for (int bj = 0; bj < 2; ++bj) {
                    float v[8];
#pragma unroll
                    for (int j = 0; j < 4; ++j) { v[j] = acc[ai][bj][m][0][j] * rstd[i]; v[4 + j] = acc[ai][bj][m][1][j] * rstd[i]; }
                    if (rot) {
#pragma unroll
                        for (int e = 0; e < 8; ++e) {
                            const float p = __shfl_xor(v[e], 32);
                            const float c = cs[e >> 1][(e & 1) * 2], sn = cs[e >> 1][(e & 1) * 2 + 1];
                            v[e] = v[e] * c + sgn * p * sn;
                        }
                    }
                    if (gel) {
#pragma unroll
                        for (int e = 0; e < 8; ++e) v[e] = gelu_tanh(v[e]);
                    }
                    if (st) {
#pragma unroll
                        for (int e = 0; e < 8; ++e) { rs += v[e]; rq += v[e] * v[e]; }
                    }
                    u32x4 w; w.x = cvt_pk_bf16(v[0], v[1]); w.y = cvt_pk_bf16(v[2], v[3]); w.z = cvt_pk_bf16(v[4], v[5]); w.w = cvt_pk_bf16(v[6], v[7]);
                    *(u32x4*)(O + (size_t)row * ldc + col0 + bj * HALF) = w;
                }
                if (st) {
                    rs += __shfl_xor(rs, 16); rs += __shfl_xor(rs, 32);
                    rq += __shfl_xor(rq, 16); rq += __shfl_xor(rq, 32);
                    if (fq == 0) { fs_add(stats + 2 * row, rs); fs_add(stats + 2 * row + 1, rq); }
                }
            }
    }
};
struct EpiRes {
    static constexpr bool PERM = true;
    const float* base32; bf16_t* xb; u64* ss;
    __device__ __forceinline__ void load32(f32x4 (&b)[2][2], size_t off) const {
#pragma unroll
        for (int bj = 0; bj < 2; ++bj)
#pragma unroll
            for (int n = 0; n < 2; ++n) b[bj][n] = __builtin_nontemporal_load((const f32x4*)(base32 + off + bj * HALF + n * 4));
    }
    __device__ __forceinline__ void operator()(const f32x4 (&acc)[2][2][4][2], const Unit& u, int wr, int wc, int fr, int fq) const {
        const int row0 = u.pm * BM + wr * 64 + fr, col0 = u.pn * BM + wc * 32 + 8 * fq;
        f32x4 b[2][2], bn[2][2];
        if (base32) load32(bn, (size_t)row0 * 2048 + col0);
#pragma unroll
        for (int ai = 0; ai < 2; ++ai) {
#pragma unroll
            for (int m = 0; m < 4; ++m) {
                const int row = row0 + ai * HALF + m * 16;
                const size_t off = (size_t)row * 2048 + col0;
                if (base32) {
#pragma unroll
                    for (int bj = 0; bj < 2; ++bj)
#pragma unroll
                        for (int n = 0; n < 2; ++n) b[bj][n] = bn[bj][n];
                    const int i1 = ai * 4 + m + 1;
                    if (i1 < 8) load32(bn, (size_t)(row0 + (i1 >> 2) * HALF + (i1 & 3) * 16) * 2048 + col0);
                } else {
#pragma unroll
                    for (int bj = 0; bj < 2; ++bj) { const u32x4 w = *(const u32x4*)(xb + off + bj * HALF);
                        b[bj][0] = (f32x4){bf_lo(w.x), bf_hi(w.x), bf_lo(w.y), bf_hi(w.y)}; b[bj][1] = (f32x4){bf_lo(w.z), bf_hi(w.z), bf_lo(w.w), bf_hi(w.w)}; }
                }
                float q = 0.f;
#pragma unroll
                for (int bj = 0; bj < 2; ++bj) {
                    const f32x4 v0 = b[bj][0] + acc[ai][bj][m][0], v1 = b[bj][1] + acc[ai][bj][m][1];
                    q += (v0.x * v0.x + v0.y * v0.y) + (v0.z * v0.z + v0.w * v0.w) + (v1.x * v1.x + v1.y * v1.y) + (v1.z * v1.z + v1.w * v1.w);
                    u32x4 w; w.x = cvt_pk_bf16(v0.x, v0.y); w.y = cvt_pk_bf16(v0.z, v0.w); w.z = cvt_pk_bf16(v1.x, v1.y); w.w = cvt_pk_bf16(v1.z, v1.w);
                    *(u32x4*)(xb + off + bj * HALF) = w;
                }
                if (ss) { q += __shfl_xor(q, 16); q += __shfl_xor(q, 32); if (fq == 0) fx_add(ss + row, q); }
            }
        }
    }
};
struct EpiGU {
    static constexpr bool PERM = true;
    bf16_t* O; const u64* ss;
    __device__ __forceinline__ void operator()(const f32x4 (&acc)[2][2][4][2], const Unit& u, int wr, int wc, int fr, int fq) const {
        const int row0 = u.pm * BM + wr * 64 + fr, col0 = u.pn * HALF + wc * 32 + 8 * fq;
        float rs8[8];
#pragma unroll
        for (int i = 0; i < 8; ++i) rs8[i] = fx_get(ss + row0 + (i >> 2) * HALF + (i & 3) * 16);
#pragma unroll
        for (int ai = 0; ai < 2; ++ai)
#pragma unroll
            for (int m = 0; m < 4; ++m) {
                const float rstd = rsqrtf(rs8[ai * 4 + m] * (1.0f / 2048.0f) + 1e-6f);
                float v[8];
#pragma unroll
                for (int n = 0; n < 2; ++n)
#pragma unroll
                    for (int j = 0; j < 4; ++j) v[4 * n + j] = silu(acc[ai][0][m][n][j] * rstd) * (acc[ai][1][m][n][j] * rstd);
                u32x4 w; w.x = cvt_pk_bf16(v[0], v[1]); w.y = cvt_pk_bf16(v[2], v[3]); w.z = cvt_pk_bf16(v[4], v[5]); w.w = cvt_pk_bf16(v[6], v[7]);
                *(u32x4*)(O + (size_t)(row0 + ai * HALF + m * 16) * FF + col0) = w;
            }
    }
};

template <class Epi, bool ALIGN_EPI = true, bool SP2 = true>
__device__ __forceinline__ void gemm_phase(LAS unsigned char* lds, const Gemm g, const Order& S, const Epi& E) {
    const int tid = threadIdx.x, wid = __builtin_amdgcn_readfirstlane(tid >> 6), lane = tid & 63, wr = wid >> 2, wc = wid & 3, fr = lane & 15, fq = lane >> 4;
    const int K = g.K, nt = K / BK;
    unsigned voffA[2], voffB[2];
#pragma unroll
    for (int i = 0; i < 2; ++i) { int R, C; stage_rc(tid * 16 + i * 8192, R, C); const int Rb = Epi::PERM ? ((R & ~31) + perm32(R & 31)) : R;
        voffA[i] = (unsigned)(R * K + C) * 2u; voffB[i] = (unsigned)(Rb * K + C) * 2u; }
    const unsigned kstep = (unsigned)(BK * 2);
    const unsigned hstep = (unsigned)HALF * (unsigned)K * 2u;
    const unsigned tstep = 2u * hstep;
    const __amdgpu_buffer_rsrc_t rA = __builtin_amdgcn_make_buffer_rsrc((void*)g.A, (short)0, (int)((unsigned)g.M * (unsigned)K * 2u), 0x00020000);
    const __amdgpu_buffer_rsrc_t rB = __builtin_amdgcn_make_buffer_rsrc((void*)g.Bt, (short)0, (int)((unsigned)g.N * (unsigned)K * 2u), 0x00020000);
    const unsigned ldsw = (unsigned)wid * 1024u;
    const int aoff = lds_byte(wr * 64 + fr, fq * 8), boff = lds_byte(wc * 32 + fr, fq * 8);
#define PG8_SA(b, h) (((b) * 2 + (h)) * HTB)
#define PG8_SB(b, h) ((4 + (b) * 2 + (h)) * HTB)
#define PG8_STAGE(bufoff, rsrc, soff, voff) do { _Pragma("unroll") for (int _i = 0; _i < 2; ++_i) \
        __builtin_amdgcn_raw_ptr_buffer_load_lds((rsrc), (LAS unsigned*)(lds + (bufoff) + ldsw + _i * 8192), 16, (int)(voff)[_i], (int)(soff), 0, 0); } while (0)
#define PG8_LDA(dst, b, h) do { _Pragma("unroll") for (int m = 0; m < 4; ++m) _Pragma("unroll") for (int k = 0; k < 2; ++k) dst[m][k] = *(const LAS bf16x8*)(lds + PG8_SA(b, h) + aoff + m * 2048 + k * 1024); } while (0)
#define PG8_LDB(dst, b, h) do { _Pragma("unroll") for (int n = 0; n < 2; ++n) _Pragma("unroll") for (int k = 0; k < 2; ++k) dst[n][k] = *(const LAS bf16x8*)(lds + PG8_SB(b, h) + boff + n * 2048 + k * 1024); } while (0)
#define PG8_MMA(ai, bj, At, Bt) do { __builtin_amdgcn_s_setprio(1); _Pragma("unroll") for (int m = 0; m < 4; ++m) _Pragma("unroll") for (int n = 0; n < 2; ++n) _Pragma("unroll") for (int k = 0; k < 2; ++k) \
        acc[ai][bj][m][n] = __builtin_amdgcn_mfma_f32_16x16x32_bf16(Bt[n][k], At[m][k], acc[ai][bj][m][n], 0, 0, 0); __builtin_amdgcn_s_setprio(0); } while (0)
#define PG8_WAIT_V(n) asm volatile("s_waitcnt vmcnt(" #n ")" ::: "memory")
#define PG8_WAIT_L(n) asm volatile("s_waitcnt lgkmcnt(" #n ")" ::: "memory")
#define PG8_BAR __builtin_amdgcn_s_barrier()
#define PG8_SCHED __builtin_amdgcn_sched_barrier(0)
    Unit cur, nxt; int ui = 0;
    if (!S.next(0, cur)) return;
    f32x4 acc[2][2][4][2];
#pragma unroll
    for (int a = 0; a < 2; ++a)
#pragma unroll
        for (int b = 0; b < 2; ++b)
#pragma unroll
            for (int m = 0; m < 4; ++m)
#pragma unroll
                for (int n = 0; n < 2; ++n) acc[a][b][m][n] = (f32x4){0.f, 0.f, 0.f, 0.f};
    bf16x8 At[4][2], B0[2][2], B1[2][2];
    unsigned cA = (unsigned)cur.pm * tstep, cB = (unsigned)cur.pn * tstep;
    if constexpr (SP2) {
        PG8_STAGE(PG8_SB(0, 0), rB, cB, voffB); PG8_STAGE(PG8_SB(0, 1), rB, cB + hstep, voffB); PG8_STAGE(PG8_SA(0, 0), rA, cA, voffA); PG8_STAGE(PG8_SA(0, 1), rA, cA + hstep, voffA);
        if (wr == 1) PG8_BAR;
        PG8_WAIT_V(2); PG8_BAR;
        PG8_STAGE(PG8_SB(1, 0), rB, cB + kstep, voffB); PG8_STAGE(PG8_SA(1, 0), rA, cA + kstep, voffA); PG8_STAGE(PG8_SB(1, 1), rB, cB + hstep + kstep, voffB);
        PG8_WAIT_V(6); PG8_BAR;
    } else {
        PG8_STAGE(PG8_SB(0, 0), rB, cB, voffB); PG8_STAGE(PG8_SA(0, 0), rA, cA, voffA); PG8_STAGE(PG8_SB(0, 1), rB, cB + hstep, voffB); PG8_STAGE(PG8_SA(0, 1), rA, cA + hstep, voffA);
        if (wr == 1) PG8_BAR;
        PG8_WAIT_V(4); PG8_BAR;
        PG8_STAGE(PG8_SB(1, 0), rB, cB + kstep, voffB); PG8_STAGE(PG8_SA(1, 0), rA, cA + kstep, voffA); PG8_STAGE(PG8_SB(1, 1), rB, cB + hstep + kstep, voffB);
        PG8_WAIT_V(6); PG8_BAR;
    }
    for (;;) {
        const bool has_next = S.next(ui + 1, nxt);
        const unsigned nA = has_next ? (unsigned)nxt.pm * tstep : cA, nB = has_next ? (unsigned)nxt.pn * tstep : cB;
        for (int t = 0; t < nt; t += 2) {
            const bool last = (t == nt - 2);
            const unsigned a1 = cA + (unsigned)(t + 1) * kstep;
            const unsigned a2 = last ? nA : cA + (unsigned)(t + 2) * kstep, b2 = last ? nB : cB + (unsigned)(t + 2) * kstep;
            const unsigned a3 = a2 + kstep, b3 = b2 + kstep;
            if constexpr (SP2) {
            PG8_LDB(B0, 0, 0); PG8_LDB(B1, 0, 1); PG8_SCHED; PG8_LDA(At, 0, 0); PG8_STAGE(PG8_SA(1, 1), rA, a1 + hstep, voffA);
            PG8_WAIT_V(8); PG8_WAIT_L(0); PG8_BAR; PG8_MMA(0, 0, At, B0); PG8_MMA(0, 1, At, B1); PG8_BAR; PG8_SCHED;
            PG8_LDA(At, 0, 1); PG8_STAGE(PG8_SB(0, 0), rB, b2, voffB); PG8_STAGE(PG8_SB(0, 1), rB, b2 + hstep, voffB); PG8_STAGE(PG8_SA(0, 0), rA, a2, voffA);
            PG8_WAIT_V(8); PG8_WAIT_L(0); PG8_BAR; PG8_MMA(1, 0, At, B0); PG8_MMA(1, 1, At, B1); PG8_BAR; PG8_SCHED;
            PG8_LDB(B0, 1, 0); PG8_LDB(B1, 1, 1); PG8_SCHED; PG8_LDA(At, 1, 0); PG8_STAGE(PG8_SA(0, 1), rA, a2 + hstep, voffA);
            PG8_WAIT_V(8); PG8_WAIT_L(0); PG8_BAR; PG8_MMA(0, 0, At, B0); PG8_MMA(0, 1, At, B1); PG8_BAR; PG8_SCHED;
            PG8_LDA(At, 1, 1); PG8_STAGE(PG8_SB(1, 0), rB, b3, voffB); PG8_STAGE(PG8_SB(1, 1), rB, b3 + hstep, voffB); PG8_STAGE(PG8_SA(1, 0), rA, a3, voffA);
            PG8_WAIT_V(8); PG8_WAIT_L(0); PG8_BAR; PG8_MMA(1, 0, At, B0); PG8_MMA(1, 1, At, B1); PG8_BAR; PG8_SCHED;
            } else {
            PG8_LDB(B0, 0, 0); PG8_SCHED; PG8_LDA(At, 0, 0); PG8_STAGE(PG8_SA(1, 1), rA, a1 + hstep, voffA);
            PG8_WAIT_L(8); PG8_BAR; PG8_WAIT_L(0); PG8_MMA(0, 0, At, B0); PG8_BAR; PG8_SCHED;
            PG8_LDB(B1, 0, 1); PG8_STAGE(PG8_SB(0, 0), rB, b2, voffB);
            PG8_BAR; PG8_WAIT_L(0); PG8_MMA(0, 1, At, B1); PG8_BAR;
            PG8_LDA(At, 0, 1); PG8_STAGE(PG8_SA(0, 0), rA, a2, voffA);
            PG8_BAR; PG8_WAIT_L(0); PG8_MMA(1, 0, At, B0); PG8_BAR; PG8_SCHED;
            PG8_STAGE(PG8_SB(0, 1), rB, b2 + hstep, voffB);
            PG8_WAIT_V(6); PG8_BAR; PG8_MMA(1, 1, At, B1); PG8_BAR;
            PG8_LDB(B0, 1, 0); PG8_SCHED; PG8_LDA(At, 1, 0); PG8_STAGE(PG8_SA(0, 1), rA, a2 + hstep, voffA);
            PG8_WAIT_L(8); PG8_BAR; PG8_WAIT_L(0); PG8_MMA(0, 0, At, B0); PG8_BAR; PG8_SCHED;
            PG8_LDB(B1, 1, 1); PG8_STAGE(PG8_SB(1, 0), rB, b3, voffB);
            PG8_BAR; PG8_WAIT_L(0); PG8_MMA(0, 1, At, B1); PG8_BAR;
            PG8_LDA(At, 1, 1); PG8_STAGE(PG8_SA(1, 0), rA, a3, voffA);
            PG8_BAR; PG8_WAIT_L(0); PG8_MMA(1, 0, At, B0); PG8_BAR; PG8_SCHED;
            PG8_STAGE(PG8_SB(1, 1), rB, b3 + hstep, voffB);
            PG8_WAIT_V(6); PG8_BAR; PG8_MMA(1, 1, At, B1); PG8_BAR;
            }
        }
        if constexpr (ALIGN_EPI) { if (wr == 0) PG8_BAR; }
        { int fr_e = (int)(threadIdx.x & 15u), fq_e = (int)((threadIdx.x >> 4) & 3u);
          asm volatile("" : "+v"(fr_e), "+v"(fq_e));
          E(acc, cur, wr, wc, fr_e, fq_e); }
        if (!has_next) break;
#pragma unroll
        for (int a = 0; a < 2; ++a)
#pragma unroll
            for (int b = 0; b < 2; ++b)
#pragma unroll
                for (int m = 0; m < 4; ++m)
#pragma unroll
                    for (int n = 0; n < 2; ++n) acc[a][b][m][n] = (f32x4){0.f, 0.f, 0.f, 0.f};
        cur = nxt; cA = nA; cB = nB; ++ui;
        if constexpr (ALIGN_EPI) { if (wr == 1) PG8_BAR; }
    }
    PG8_WAIT_V(0);
    if constexpr (!ALIGN_EPI) { if (wr == 0) PG8_BAR; }
    PG8_BAR;
#undef PG8_SA
#undef PG8_SB
#undef PG8_STAGE
#undef PG8_LDA
#undef PG8_LDB
#undef PG8_MMA
#undef PG8_WAIT_V
#undef PG8_WAIT_L
#undef PG8_BAR
#undef PG8_SCHED
}
}

constexpr int CV_PREP = 9728, CV_S7 = 11072, CV_S5 = 16192, CV_S1 = 20992, CV_END = 23808;
struct TileDesc { const float* src; bf16_t* dst; const float* gk; int N, K; };
__device__ __forceinline__ TileDesc tile_make(const float* W, int K, int N, bf16_t* WT, int mode, int r, const float* gain) {
    const int nblk = N >> 6, kb = r / nblk, nb = r - kb * nblk, n0 = nb * 64, k0 = kb * 64;
    int drow0 = n0;
    if (mode) drow0 = 256 * (n0 >> 7) + (n0 & 127) + (mode == 2 ? 128 : 0);
    TileDesc d; d.src = W + (size_t)k0 * N + n0; d.dst = WT + (size_t)drow0 * K + k0; d.gk = gain ? gain + k0 : nullptr; d.N = N; d.K = K; return d;
}
__device__ __forceinline__ TileDesc tile_decode(const Params __attribute__((address_space(4)))* pp, unsigned char* ws, int it) {
    constexpr int TG = 2816;
    int r = it;
    if (r < 2560) return tile_make(pp->attn_w_in, 2048, 5120, (bf16_t*)(ws + O_WIN0), 0, r, nullptr); r -= 2560;
    if (r < 512) return tile_make(pp->attn_w_out, 1024, 2048, (bf16_t*)(ws + O_WOUT0), 0, r, nullptr); r -= 512;
    if (r < 1024) { const int l = r >> 9; return tile_make(pp->w_mem_kv + (size_t)l * 2048 * 1024, 2048, 1024, (bf16_t*)(ws + O_WKV) + (size_t)l * 1024 * 2048, 0, r & 511, nullptr); } r -= 1024;
    if (r < TG) return tile_make(pp->w_gate, 2048, 5632, (bf16_t*)(ws + O_WGU), 1, r, pp->ffn_norm); r -= TG;
    if (r < TG) return tile_make(pp->w_up, 2048, 5632, (bf16_t*)(ws + O_WGU), 2, r, pp->ffn_norm); r -= TG;
    if (r < TG) return tile_make(pp->w_up + (size_t)2048 * 5632, 2048, 5632, (bf16_t*)(ws + O_WGU) + (size_t)11264 * 2048, 2, r, pp->ffn_norm + DM); r -= TG;
    if (r < TG) return tile_make(pp->w_gate + (size_t)2048 * 5632, 2048, 5632, (bf16_t*)(ws + O_WGU) + (size_t)11264 * 2048, 1, r, pp->ffn_norm + DM); r -= TG;
    if (r < 1792) return tile_make(pp->sgu_w_in, 2048, 3584, (bf16_t*)(ws + O_WIN1), 0, r, pp->mix_norm + DM); r -= 1792;
    if (r < 1024) return tile_make(pp->sgu_w_out, 2048, 2048, (bf16_t*)(ws + O_WOUT1), 0, r, nullptr); r -= 1024;
    if (r < TG) return tile_make(pp->w_down, 5632, 2048, (bf16_t*)(ws + O_WDN), 0, r, nullptr); r -= TG;
    return tile_make(pp->w_down + (size_t)5632 * 2048, 5632, 2048, (bf16_t*)(ws + O_WDN) + (size_t)2048 * 5632, 0, r, nullptr);
}
__device__ __forceinline__ void tile_load(const TileDesc& d, f32x4 (&v)[16], int lane) {
    const float* p = d.src + (size_t)(lane >> 4) * d.N + 4 * (lane & 15);
#pragma unroll
    for (int i = 0; i < 16; ++i) v[i] = __builtin_nontemporal_load((const f32x4*)(p + (size_t)(4 * i) * d.N));
}
__device__ __forceinline__ void tile_store(const TileDesc& d, const f32x4 (&v)[16], LAS float* scr, int lane) {
    const int r4 = lane >> 4, c4 = lane & 15;
#pragma unroll
    for (int i = 0; i < 16; ++i) {
        const float gg = d.gk ? d.gk[4 * i + r4] : 1.0f;
        LAS float* q = scr + (4 * i + r4) * 65 + 4 * c4;
        q[0] = v[i].x * gg; q[1] = v[i].y * gg; q[2] = v[i].z * gg; q[3] = v[i].w * gg;
    }
    LDS_WAIT();
    const int c = lane & 7;
#pragma unroll
    for (int j = 0; j < 8; ++j) {
        const int n = (lane >> 3) + 8 * j; const LAS float* s = scr + (8 * c) * 65 + n;
        u32x4 o; o.x = cvt_pk_bf16(s[0 * 65], s[1 * 65]); o.y = cvt_pk_bf16(s[2 * 65], s[3 * 65]); o.z = cvt_pk_bf16(s[4 * 65], s[5 * 65]); o.w = cvt_pk_bf16(s[6 * 65], s[7 * 65]);
        *(u32x4*)(d.dst + (size_t)n * d.K + 8 * c) = o;
    }
    LDS_WAIT();
}
__device__ __forceinline__ void convert_tiles(const Params __attribute__((address_space(4)))* pp, unsigned char* ws, int lo, int hi, int w0, int nw, LAS float* scr, int lane) {
    int it = lo + w0;
    if (it >= hi) return;
    TileDesc d0 = tile_decode(pp, ws, it);
    f32x4 v[16], vn[16];
    tile_load(d0, v, lane);
    for (;;) {
        const int it1 = it + nw; const bool has = it1 < hi;
        TileDesc d1 = d0;
        if (has) { d1 = tile_decode(pp, ws, it1); tile_load(d1, vn, lane); }
        tile_store(d0, v, scr, lane);
        if (!has) break;
#pragma unroll
        for (int i = 0; i < 16; ++i) v[i] = vn[i];
        d0 = d1; it = it1;
    }
}
__device__ __forceinline__ void rms_row(const float* xrow, const float* g, bf16_t* obf, float* of32, int lane) {
    const f32x4* xr = (const f32x4*)xrow + lane; const f32x4* gr = (const f32x4*)g + lane;
    f32x4 v[8]; float s = 0.f;
#pragma unroll
    for (int j = 0; j < 8; ++j) { v[j] = __builtin_nontemporal_load(xr + 64 * j); s += (v[j].x * v[j].x + v[j].y * v[j].y) + (v[j].z * v[j].z + v[j].w * v[j].w); }
    const float rstd = rsqrtf(wave_sum(s) * (1.0f / 2048.0f) + 1e-6f);
    if (obf) {
        u32x2* o8 = (u32x2*)obf + lane;
#pragma unroll
        for (int j = 0; j < 8; ++j) { const f32x4 gg = gr[64 * j]; const f32x4 o = v[j] * rstd * gg; u32x2 w; w.x = cvt_pk_bf16(o.x, o.y); w.y = cvt_pk_bf16(o.z, o.w); o8[64 * j] = w; }
    } else {
        f32x4* o16 = (f32x4*)of32 + lane;
#pragma unroll
        for (int j = 0; j < 8; ++j) { const f32x4 gg = gr[64 * j]; o16[64 * j] = v[j] * rstd * gg; }
    }
}

constexpr int KS_PITCH = 272, VT_PITCH = 528, VT_OFF = 256 * KS_PITCH;
struct HalfRegs { u32x4 k[4]; u32x4 va[2], vb[2]; };
__device__ __forceinline__ void half_fetch(HalfRegs& h, const bf16_t* kp, const bf16_t* vp, unsigned kvs, int tid) {
    const int wid = tid >> 6, lane = tid & 63;
    { const int ch = tid & 15, r0 = tid >> 4;
#pragma unroll
      for (int i = 0; i < 4; ++i) h.k[i] = *(const u32x4*)(kp + (size_t)(r0 + 32 * i) * kvs + 8 * ch); }
    { const int cl = lane & 3, pair = (lane >> 2) + 16 * (wid & 3);
      const bf16_t* v0 = vp + (size_t)(2 * pair) * kvs;
#pragma unroll
      for (int i = 0; i < 2; ++i) { const int c = cl + 4 * ((wid >> 2) + 2 * i); h.va[i] = *(const u32x4*)(v0 + 8 * c); h.vb[i] = *(const u32x4*)(v0 + kvs + 8 * c); } }
}
__device__ __forceinline__ void half_commit(const HalfRegs& h, LAS unsigned char* lds, int slot, int tid) {
    const int wid = tid >> 6, lane = tid & 63;
    LAS unsigned char* Ks = lds + slot * (128 * KS_PITCH);
    LAS unsigned char* Vt = lds + VT_OFF + slot * 256;
    { const int ch = tid & 15, r0 = tid >> 4;
#pragma unroll
      for (int i = 0; i < 4; ++i) *(LAS u32x4*)(Ks + (r0 + 32 * i) * KS_PITCH + ch * 16) = h.k[i]; }
    { const int cl = lane & 3, pair = (lane >> 2) + 16 * (wid & 3);
#pragma unroll
      for (int i = 0; i < 2; ++i) { const int c = cl + 4 * ((wid >> 2) + 2 * i); const u32x4 a = h.va[i], b = h.vb[i];
          LAS unsigned char* dst = Vt + (8 * c) * VT_PITCH + 4 * pair;
          *(LAS unsigned*)(dst + 0 * VT_PITCH) = (a.x & 0xffffu) | (b.x << 16);
          *(LAS unsigned*)(dst + 1 * VT_PITCH) = (a.x >> 16) | (b.x & 0xffff0000u);
          *(LAS unsigned*)(dst + 2 * VT_PITCH) = (a.y & 0xffffu) | (b.y << 16);
          *(LAS unsigned*)(dst + 3 * VT_PITCH) = (a.y >> 16) | (b.y & 0xffff0000u);
          *(LAS unsigned*)(dst + 4 * VT_PITCH) = (a.z & 0xffffu) | (b.z << 16);
          *(LAS unsigned*)(dst + 5 * VT_PITCH) = (a.z >> 16) | (b.z & 0xffff0000u);
          *(LAS unsigned*)(dst + 6 * VT_PITCH) = (a.w & 0xffffu) | (b.w << 16);
          *(LAS unsigned*)(dst + 7 * VT_PITCH) = (a.w >> 16) | (b.w & 0xffff0000u); } }
}
__device__ __forceinline__ void q_fetch(bf16x8 (&qf)[4], const bf16_t* qp, unsigned qs, int tid) {
    const int wid = tid >> 6, lane = tid & 63, l15 = lane & 15, quad = lane >> 4;
    const bf16_t* qrow = qp + (size_t)(16 * wid + l15) * qs + 8 * quad;
#pragma unroll
    for (int ks = 0; ks < 4; ++ks) qf[ks] = *(const bf16x8*)(qrow + 32 * ks);
}
__device__ __forceinline__ void attn_compute(LAS unsigned char* lds, const bf16x8 (&qf)[4], int p, bf16_t* op, unsigned os, float* lp, unsigned ls, bool masked, bool first, int tid) {
    const int wid = __builtin_amdgcn_readfirstlane(tid >> 6), lane = tid & 63, l15 = lane & 15, quad = lane >> 4;
    LAS unsigned char* Ks = lds;
    LAS unsigned char* Vt = lds + VT_OFF;
    f32x4 s[16];
    const int qi = 16 * wid + l15;
#pragma unroll
    for (int kt = 0; kt < 16; ++kt) {
        f32x4 a = (f32x4){0.f, 0.f, 0.f, 0.f};
        if (!masked || (kt >= wid && kt <= wid + 8 && (!first || kt >= 8))) {
            const int pt = (kt + 8 * p) & 15;
#pragma unroll
            for (int ks = 0; ks < 4; ++ks) { const bf16x8 kf = *(const LAS bf16x8*)(Ks + (16 * pt + l15) * KS_PITCH + ks * 64 + quad * 16);
                a = __builtin_amdgcn_mfma_f32_16x16x32_bf16(kf, qf[ks], a, 0, 0, 0); }
        }
        s[kt] = a;
    }
    constexpr float SC = 0.08838834764831845f * 1.4426950408889634f;
    float mx = -3.0e38f;
#pragma unroll
    for (int kt = 0; kt < 16; ++kt) {
        if (!masked || (kt >= wid && kt <= wid + 8 && (!first || kt >= 8))) {
            if (masked && (kt == wid || kt == wid + 8)) {
#pragma unroll
                for (int j = 0; j < 4; ++j) { const int key = 16 * kt + 4 * quad + j; if (!(key >= qi && key <= qi + 128)) s[kt][j] = -1.0e30f; }
            }
            mx = fmaxf(mx, fmaxf(fmaxf(s[kt][0], s[kt][1]), fmaxf(s[kt][2], s[kt][3])));
        }
    }
    mx = fmaxf(mx, __shfl_xor(mx, 16)); mx = fmaxf(mx, __shfl_xor(mx, 32));
    const float nb = -mx * SC;
    float sum = 0.f;
#pragma unroll
    for (int kt = 0; kt < 16; ++kt) {
        if (!masked || (kt >= wid && kt <= wid + 8 && (!first || kt >= 8))) {
#pragma unroll
            for (int j = 0; j < 4; ++j) { const float pp_ = __builtin_amdgcn_exp2f(fmaf(s[kt][j], SC, nb)); s[kt][j] = pp_; sum += pp_; }
        }
    }
    sum += __shfl_xor(sum, 16); sum += __shfl_xor(sum, 32);
    bf16x8 pb[8];
#pragma unroll
    for (int t = 0; t < 8; ++t) { u32x4 w; w.x = cvt_pk_bf16(s[2 * t][0], s[2 * t][1]); w.y = cvt_pk_bf16(s[2 * t][2], s[2 * t][3]);
        w.z = cvt_pk_bf16(s[2 * t + 1][0], s[2 * t + 1][1]); w.w = cvt_pk_bf16(s[2 * t + 1][2], s[2 * t + 1][3]); pb[t] = __builtin_bit_cast(bf16x8, w); }
    const float inv = 1.0f / sum;
    bf16_t* orow = op + (size_t)qi * os + 4 * quad;
#pragma unroll
    for (int dt = 0; dt < 8; ++dt) {
        f32x4 a = (f32x4){0.f, 0.f, 0.f, 0.f};
#pragma unroll
        for (int t = 0; t < 8; ++t) {
            if (!masked || (2 * t + 1 >= wid && 2 * t <= wid + 8)) {
                const int pt = (t + 4 * p) & 7;
                const LAS unsigned char* vr = Vt + (16 * dt + l15) * VT_PITCH + (32 * pt + 4 * quad) * 2;
                const u32x2 lo = *(const LAS u32x2*)vr, hi = *(const LAS u32x2*)(vr + 32);
                u32x4 w; w.x = lo.x; w.y = lo.y; w.z = hi.x; w.w = hi.y;
                a = __builtin_amdgcn_mfma_f32_16x16x32_bf16(__builtin_bit_cast(bf16x8, w), pb[t], a, 0, 0, 0);
            }
        }
        u32x2 w; w.x = cvt_pk_bf16(a[0] * inv, a[1] * inv); w.y = cvt_pk_bf16(a[2] * inv, a[3] * inv);
        *(u32x2*)(orow + 16 * dt) = w;
    }
    if (lp && quad == 0) lp[(size_t)qi * ls] = (mx * SC + __log2f(sum)) * 0.6931471805599453f;
}
__device__ __forceinline__ void attn_run(LAS unsigned char* lds, int n0, int nit, const bf16_t* qp, unsigned qbs, unsigned qs, const bf16_t* kp, const bf16_t* vp, unsigned kbs, unsigned kvs,
                                         bf16_t* op, unsigned obs, unsigned os, float* lp, unsigned lbs, unsigned ls, bool masked, int tid) {
    HalfRegs hr; bf16x8 qf[4];
    __syncthreads();
    {
        HalfRegs h2;
        if (kbs == 0) {
            half_fetch(hr, kp, vp, kvs, tid); half_fetch(h2, kp + (size_t)128 * kvs, vp + (size_t)128 * kvs, kvs, tid);
            q_fetch(qf, qp + (size_t)n0 * qbs, qs, tid);
            half_commit(hr, lds, 0, tid); half_commit(h2, lds, 1, tid);
        } else {
            const int mprev = n0 > 0 ? n0 - 1 : 0;
            half_fetch(hr, kp + (size_t)mprev * kbs, vp + (size_t)mprev * kbs, kvs, tid); half_fetch(h2, kp + (size_t)n0 * kbs, vp + (size_t)n0 * kbs, kvs, tid);
            q_fetch(qf, qp + (size_t)n0 * qbs, qs, tid);
            half_commit(hr, lds, (n0 - 1) & 1, tid); half_commit(h2, lds, n0 & 1, tid);
        }
    }
    __syncthreads();
#pragma unroll 1
    for (int j = 0; j < nit; ++j) {
        const int n = n0 + j; const bool more = j + 1 < nit;
        if (more && kbs != 0) half_fetch(hr, kp + (size_t)(n + 1) * kbs, vp + (size_t)(n + 1) * kbs, kvs, tid);
        attn_compute(lds, qf, kbs == 0 ? 0 : ((n - 1) & 1), op + (size_t)n * obs, os, lp ? lp + (size_t)n * lbs : nullptr, ls, masked, masked && n == 0, tid);
        if (more) {
            __syncthreads();
            q_fetch(qf, qp + (size_t)(n + 1) * qbs, qs, tid);
            if (kbs != 0) half_commit(hr, lds, (n + 1) & 1, tid);
            __syncthreads();
        }
    }
}

__device__ __forceinline__ void sgu_item(LAS unsigned char* lds, const bf16_t* proj, const u64* stats, const float* lng, const float* lnb,
                                         const bf16_t* wsp, const float* bsp, bf16_t* cat, int n, int g, int tid) {
    const int wid = __builtin_amdgcn_readfirstlane(tid >> 6), lane = tid & 63, l15 = lane & 15, quad = lane >> 4;
    LAS unsigned char* Vt = lds + VT_OFF;
    __syncthreads();
    bf16x8 wf[4];
    { const bf16_t* wrow = wsp + (size_t)g * 16384 + (size_t)(16 * wid + l15) * 128 + 8 * quad;
#pragma unroll
      for (int ks = 0; ks < 4; ++ks) wf[ks] = *(const bf16x8*)(wrow + 32 * ks); }
    { const int cl = lane & 3, pair = (lane >> 2) + 16 * (wid & 3);
      const int row0 = 128 * n + 2 * pair;
      const f32x2 st0 = (f32x2){fs_get(stats + 2 * row0), fs_get(stats + 2 * row0 + 1)}, st1 = (f32x2){fs_get(stats + 2 * row0 + 2), fs_get(stats + 2 * row0 + 3)};
      const float mu0 = st0.x * (1.0f / 1536.0f), mu1 = st1.x * (1.0f / 1536.0f);
      const float rs0 = rsqrtf(fmaxf(st0.y * (1.0f / 1536.0f) - mu0 * mu0, 0.f) + 1e-5f), rs1 = rsqrtf(fmaxf(st1.y * (1.0f / 1536.0f) - mu1 * mu1, 0.f) + 1e-5f);
      const bf16_t* v0 = proj + (size_t)row0 * NIN1 + 1536 + 128 * g;
#pragma unroll
      for (int i = 0; i < 2; ++i) { const int c = cl + 4 * ((wid >> 2) + 2 * i);
          const u32x4 a = *(const u32x4*)(v0 + 8 * c), b = *(const u32x4*)(v0 + NIN1 + 8 * c);
          const f32x4 g0 = *(const f32x4*)(lng + 128 * g + 8 * c), g1 = *(const f32x4*)(lng + 128 * g + 8 * c + 4);
          const f32x4 b0 = *(const f32x4*)(lnb + 128 * g + 8 * c), b1 = *(const f32x4*)(lnb + 128 * g + 8 * c + 4);
          const unsigned aw[4] = {a.x, a.y, a.z, a.w}, bw[4] = {b.x, b.y, b.z, b.w};
          const float gg[8] = {g0.x, g0.y, g0.z, g0.w, g1.x, g1.y, g1.z, g1.w}, bb[8] = {b0.x, b0.y, b0.z, b0.w, b1.x, b1.y, b1.z, b1.w};
          LAS unsigned char* dst = Vt + (8 * c) * VT_PITCH + 4 * pair;
#pragma unroll
          for (int e = 0; e < 8; ++e) {
              const float xa = (e & 1) ? bf_hi(aw[e >> 1]) : bf_lo(aw[e >> 1]);
              const float xb = (e & 1) ? bf_hi(bw[e >> 1]) : bf_lo(bw[e >> 1]);
              const float ya = (xa - mu0) * rs0 * gg[e] + bb[e], yb = (xb - mu1) * rs1 * gg[e] + bb[e];
              *(LAS unsigned*)(dst + e * VT_PITCH) = cvt_pk_bf16(ya, yb);
          } } }
    __syncthreads();
    const int t = 16 * wid + l15;
    const float bias = bsp[g * 128 + t];
    const size_t grow = (size_t)(128 * n + t);
    const bf16_t* urow = proj + grow * NIN1 + 128 * g + 4 * quad;
    bf16_t* orow = cat + grow * 2048 + 128 * g + 4 * quad;
#pragma unroll
    for (int ct = 0; ct < 8; ++ct) {
        f32x4 a = (f32x4){0.f, 0.f, 0.f, 0.f};
#pragma unroll
        for (int ks = 0; ks < 4; ++ks) {
            if (32 * ks <= 16 * wid + 15) {
                const bf16x8 vf = *(const LAS bf16x8*)(Vt + (16 * ct + l15) * VT_PITCH + ks * 64 + quad * 16);
                a = __builtin_amdgcn_mfma_f32_16x16x32_bf16(vf, wf[ks], a, 0, 0, 0);
            }
        }
        const u32x2 uu = *(const u32x2*)(urow + 16 * ct);
        u32x2 w; w.x = cvt_pk_bf16((a[0] + bias) * bf_lo(uu.x), (a[1] + bias) * bf_hi(uu.x)); w.y = cvt_pk_bf16((a[2] + bias) * bf_lo(uu.y), (a[3] + bias) * bf_hi(uu.y));
        *(u32x2*)(orow + 16 * ct) = w;
    }
}

#define XB_TMO      128
#define XB_XCNT(j)  (256  + 64 * (j))
#define XB_XSUB(j)  (1280 + 64 * (j))
#define XB_XGEN(j)  (2304 + 64 * (j))
#define XB_TOP      3328
#define XB_TOPGEN   3392
#define XCD_BAR_WORDS 3456
#define XB_SPIN_CAP (1u << 18)
__device__ __forceinline__ unsigned xb_ld(unsigned* p)              { return __hip_atomic_load(p, __ATOMIC_RELAXED, __HIP_MEMORY_SCOPE_AGENT); }
__device__ __forceinline__ unsigned xb_add(unsigned* p, unsigned v) { return __hip_atomic_fetch_add(p, v, __ATOMIC_RELAXED, __HIP_MEMORY_SCOPE_AGENT); }
__device__ __forceinline__ unsigned xb_xcc_id() { return (unsigned)__builtin_amdgcn_s_getreg((3 << 11) | 20) & 0xFu; }
#define XB_SPIN(cond, bar) do { unsigned _sp = 0; while (cond) { __builtin_amdgcn_s_sleep(1); \
    if ((++_sp & 255u) == 0u) { if (xb_ld(&(bar)[XB_TMO])) break; if (_sp > XB_SPIN_CAP) { atomicAdd(&(bar)[XB_TMO], 1u); break; } } } } while (0)
struct XcdBarrier { unsigned* bar; unsigned x; volatile LAS unsigned* st; };
__device__ __forceinline__ XcdBarrier xcd_barrier_post(unsigned* bar, volatile LAS unsigned* st) {
    XcdBarrier b; b.bar = bar; b.x = xb_xcc_id(); b.st = st;
    if (threadIdx.x == 0) (void)xb_add(&bar[XB_XCNT(b.x)], 1u);
    return b;
}
__device__ __forceinline__ void xcd_barrier_complete(unsigned* bar, unsigned x, unsigned& nloc, unsigned& nx) {
    const unsigned G = gridDim.x * gridDim.y * gridDim.z;
    unsigned sum, cnt, mine, sp = 0u;
    for (;;) {
        sum = 0u; cnt = 0u; mine = 0u;
#pragma unroll
        for (unsigned j = 0; j < 16; ++j) { const unsigned c = xb_ld(&bar[XB_XCNT(j)]); sum += c; cnt += (c > 0u) ? 1u : 0u; mine = (j == x) ? c : mine; }
        if (sum == G) break;
        __builtin_amdgcn_s_sleep(1);
        if ((++sp & 255u) == 0u) { if (xb_ld(&bar[XB_TMO])) break; if (sp > XB_SPIN_CAP) { atomicAdd(&bar[XB_TMO], 1u); break; } }
    }
    nloc = mine > 0u ? mine : 1u; nx = cnt > 0u ? cnt : 1u;
}
__device__ __forceinline__ void xcd_barrier(const XcdBarrier& b) {
    asm volatile("s_waitcnt vmcnt(0)" ::: "memory");
    __syncthreads();
    if (threadIdx.x == 0) {
        unsigned* bar = b.bar;
        __builtin_amdgcn_s_waitcnt(0);
        unsigned nloc = b.st[0], nx = b.st[1];
        if (nloc == 0u) { xcd_barrier_complete(bar, b.x, nloc, nx); b.st[0] = nloc; b.st[1] = nx; }
        const unsigned old = xb_add(&bar[XB_XSUB(b.x)], 1u);
        const unsigned gen = old / nloc;
        if (old + 1u == (gen + 1u) * nloc) {
            __builtin_amdgcn_fence(__ATOMIC_RELEASE, "agent");
            asm volatile("s_waitcnt vmcnt(0)" ::: "memory");
            const unsigned og = xb_add(&bar[XB_TOP], 1u);
            const unsigned tg = og / nx;
            if (og + 1u == (tg + 1u) * nx) xb_add(&bar[XB_TOPGEN], 1u);
            else XB_SPIN(xb_ld(&bar[XB_TOPGEN]) == tg, bar);
            __builtin_amdgcn_fence(__ATOMIC_ACQUIRE, "agent");
            xb_add(&bar[XB_XGEN(b.x)], 1u);
            asm volatile("s_waitcnt vmcnt(0)" ::: "memory");
        } else {
            XB_SPIN(xb_ld(&bar[XB_XGEN(b.x)]) == gen, bar);
            __builtin_amdgcn_fence(__ATOMIC_ACQUIRE, "agent");
            asm volatile("s_waitcnt vmcnt(0)" ::: "memory");
        }
    }
    __syncthreads();
}

enum { K_PREP = 0, K_GEMM_BF = 1, K_MIX = 2, K_MERGE = 3, K_GEMM_RES = 4, K_NORM = 5, K_GEMM_GU = 6 };
constexpr unsigned long long KINDS = 0x0ull | (1ull << 4) | (2ull << 8) | (3ull << 12) | (4ull << 16) | (6ull << 20) | (4ull << 24) | (1ull << 28) | (2ull << 32) | (4ull << 36) |
                                     (6ull << 40) | (4ull << 44) | (5ull << 48);
constexpr int NSTEPS = 13;
#ifndef ENMASK
#define ENMASK 0x7f
#endif
#ifndef REP_MASK
#define REP_MASK 0
#endif
#ifndef SYNC_REP
#define SYNC_REP 1
#endif

__global__ void __launch_bounds__(512, 2) fwd_megakernel(Params p) {
    extern __shared__ __attribute__((aligned(16))) unsigned char lds_raw[];
    LAS unsigned char* lds = (LAS unsigned char*)lds_raw;
    cg::grid_group grid = cg::this_grid();
    const int G = gridDim.x, bid = blockIdx.x;
    if (threadIdx.x < 4) ((LAS unsigned*)(lds + LDS_CTL))[threadIdx.x] = 0u;
    __syncthreads();
    if (p.ws == nullptr) grid.sync();
    const XcdBarrier xbar = xcd_barrier_post((unsigned*)(p.ws + O_BAR), (volatile LAS unsigned*)(lds + LDS_CTL));
#pragma unroll 1
    for (int step = 0; step < NSTEPS; ++step) {
        const int kind = (int)((KINDS >> (4 * step)) & 15ull);
        const int layer = (step >= 7) ? 1 : 0;
        const bool idem = (kind == K_PREP) || (kind == K_MIX) || (kind == K_MERGE) || (kind == K_NORM) || (kind == K_GEMM_GU) || (kind == K_GEMM_BF && layer == 0);
        const int nrep = (REP_MASK != 0 && ((REP_MASK >> kind) & 1) && idem) ? 2 : 1;
#pragma unroll 1
        for (int rep = 0; rep < nrep; ++rep) {
        int tid = threadIdx.x; asm volatile("" : "+v"(tid));
        const Params __attribute__((address_space(4)))* pp = (const Params __attribute__((address_space(4)))*)__builtin_amdgcn_kernarg_segment_ptr();
        asm volatile("" : "+s"(pp));
        unsigned char* ws = pp->ws;
        const int lane = tid & 63, wave = __builtin_amdgcn_readfirstlane(tid >> 6);
        bf16_t* WIN0 = (bf16_t*)(ws + O_WIN0); bf16_t* WOUT0 = (bf16_t*)(ws + O_WOUT0); bf16_t* WIN1 = (bf16_t*)(ws + O_WIN1); bf16_t* WOUT1 = (bf16_t*)(ws + O_WOUT1);
        bf16_t* WGU = (bf16_t*)(ws + O_WGU); bf16_t* WDN = (bf16_t*)(ws + O_WDN); bf16_t* WKV = (bf16_t*)(ws + O_WKV); bf16_t* WSP = (bf16_t*)(ws + O_WSP);
        bf16_t* H = (bf16_t*)(ws + O_H); bf16_t* AO = (bf16_t*)(ws + O_H); bf16_t* BIG = (bf16_t*)(ws + O_BIG); bf16_t* CAT = (bf16_t*)(ws + O_CAT);
        float* LSE = (float*)(ws + O_LSE); bf16_t* MEMN = (bf16_t*)(ws + O_MEMN); bf16_t* MEMKV = (bf16_t*)(ws + O_MEMKV); float* ROPE = (float*)(ws + O_ROPE); u64* STATS = (u64*)(ws + O_STATS); u64* SS = (u64*)(ws + O_SS);

        int cv_lo = 0, cv_hi = 0, cv_w0 = 0, cv_nw = 1;
        switch (kind) {
        case K_PREP: if constexpr ((ENMASK >> 0) & 1) {
            const int gw = bid * 8 + wave, NGW = G * 8;
            cv_lo = 0; cv_hi = CV_PREP; cv_w0 = gw; cv_nw = NGW;
            for (int m = gw; m < SEQ + 512; m += NGW) {
                if (m < SEQ) rms_row(pp->x + (size_t)m * DM, pp->mix_norm, H + (size_t)m * DM, nullptr, lane);
                else { const int mm = m - SEQ, l = mm >> 8, r = mm & 255; rms_row(pp->mem + (size_t)r * DM, pp->mem_norm + l * DM, MEMN + (size_t)mm * DM, nullptr, lane); }
            }
            const int gt = bid * 512 + tid, NGT = G * 512;
            for (int i = gt; i < SEQ * 16; i += NGT) {
                const int t = i >> 4, f = i & 15;
                const float inv = exp2f(-(float)f * 1.1832230355827609f);
                const float ang = (float)pp->pos[t] * inv;
                const float k = rintf(ang * 0.15915494309189535f);
                float r = fmaf(-k, 6.28125f, ang); r = fmaf(-k, 0.0019353071795864769f, r);
                ROPE[2 * i] = __cosf(r); ROPE[2 * i + 1] = __sinf(r);
            }
            for (int i = gt; i < SEQ * 6; i += NGT) STATS[i] = 0u;
            for (int i = gt; i < 12 * 128 * 128; i += NGT) { const int tt = (i >> 7) & 127, ss = i & 127; const float w = (ss <= tt) ? pp->sgu_w_spatial[i] : 0.f; WSP[i] = (bf16_t)(cvt_pk_bf16(w, 0.f) & 0xffffu); }
        } break;
        case K_GEMM_BF: if constexpr ((ENMASK >> 1) & 1) {
            const int nsub = layer ? 1 : 2;
#pragma unroll 1
            for (int sub = 0; sub < nsub; ++sub) {
                pg8::Gemm g; pg8::Order S; pg8::EpiBf E;
                if (layer == 0 && sub == 0) { g = pg8::Gemm{H, WIN0, SEQ, NIN0, DM}; S.init(SEQ, NIN0, G, bid, 0); E = pg8::EpiBf{BIG, NIN0, 12, 0, 0, 0, ROPE, STATS, nullptr}; }
                else if (layer == 0) { g = pg8::Gemm{MEMN, WKV, 512, 2048, DM}; S.init(512, 2048, G, bid, 1); E = pg8::EpiBf{MEMKV, 2048, 0, 0, 0, 0, ROPE, STATS, nullptr}; }
                else { g = pg8::Gemm{H, WIN1, SEQ, NIN1, DM}; S.init(SEQ, NIN1, G, bid, 0); E = pg8::EpiBf{BIG, NIN1, 0, 12, 6, 12, ROPE, STATS, SS + SEQ}; }
                pg8::gemm_phase<pg8::EpiBf>(lds, g, S, E);
            }
            if (rep == 0) {
                if (layer == 0) { if (bid >= 136) { cv_lo = CV_S5; cv_hi = CV_S1; cv_w0 = (bid - 136) * 8 + wave; cv_nw = (G - 136) * 8; } }
                else { if (bid >= 192) { cv_lo = CV_PREP; cv_hi = CV_S7; cv_w0 = (bid - 192) * 8 + wave; cv_nw = (G - 192) * 8; } }
            }
        } break;
        case K_MIX: if constexpr ((ENMASK >> 2) & 1) {
            if (layer == 0) {
                if (bid < 192) {
                    const int g = bid >> 6, rr = bid & 63, h = rr & 3, chain = rr >> 2;
                    const int d = (g == 0) ? 1 : ((g == 1) ? 4 : 16), rpr = 16 / d, r = chain / rpr, n0 = 4 * (chain - r * rpr);
                    const bf16_t* base = BIG + (size_t)r * NIN0 + (4 * g + h) * 128;
                    attn_run(lds, n0, 4, base, 128u * d * NIN0, (unsigned)d * NIN0, base + 1536, base + 3072, 128u * d * NIN0, (unsigned)d * NIN0,
                             AO + (size_t)g * SEQ * 512 + (size_t)r * 512 + h * 128, 128u * d * 512, (unsigned)d * 512,
                             LSE + (size_t)g * SEQ * 4 + (size_t)r * 4 + h, 128u * d * 4, (unsigned)d * 4, true, tid);
                } else {
                    const int mb = bid - 192, h = mb & 3, n0 = 4 * (mb >> 2);
                    const bf16_t* kv = MEMKV + h * 128;
                    attn_run(lds, n0, 4, BIG + 4608 + h * 128, 128u * NIN0, (unsigned)NIN0, kv, kv + 512, 0u, 2048u,
                             CAT + 512 + h * 128, 128u * 1024, 1024u, nullptr, 0u, 0u, false, tid);
                }
            } else {
#pragma unroll 1
                for (int it = bid; it < 1024; it += G) {
                    if (it >= 768) {
                        const int rem = it - 768, h = rem & 3, n = rem >> 2;
                        const bf16_t* kv = MEMKV + (size_t)256 * 2048 + 1024 + h * 128;
                        attn_run(lds, n, 1, BIG + 3072 + h * 128, 128u * NIN1, (unsigned)NIN1, kv, kv + 512, 0u, 2048u,
                                 CAT + 1536 + h * 128, 128u * 2048, 2048u, nullptr, 0u, 0u, false, tid);
                    } else {
                        const int g = it % 12, n = it / 12;
                        sgu_item(lds, BIG, STATS, pp->sgu_ln_g, pp->sgu_ln_b, WSP, pp->sgu_b_spatial, CAT, n, g, tid);
                    }
                }
            }
        } break;
        case K_MERGE: if constexpr ((ENMASK >> 3) & 1) {
            const int gt = bid * 512 + tid, NGT = G * 512;
#pragma unroll 1
            for (int i0 = gt; i0 < SEQ * 64; i0 += 4 * NGT) {
                float l0[4], l1[4], l2[4]; u32x4 a[4], b[4], c[4];
#pragma unroll
                for (int j = 0; j < 4; ++j) {
                    const int i = (i0 + j * NGT < SEQ * 64) ? i0 + j * NGT : i0;
                    const int t = i >> 6, rem = i & 63, h = rem >> 4, c8 = rem & 15;
                    l0[j] = LSE[(size_t)t * 4 + h]; l1[j] = LSE[(size_t)SEQ * 4 + t * 4 + h]; l2[j] = LSE[(size_t)2 * SEQ * 4 + t * 4 + h];
                    const size_t off = (size_t)t * 512 + h * 128 + c8 * 8;
                    a[j] = *(const u32x4*)(AO + off); b[j] = *(const u32x4*)(AO + (size_t)SEQ * 512 + off); c[j] = *(const u32x4*)(AO + (size_t)2 * SEQ * 512 + off);
                }
#pragma unroll
                for (int j = 0; j < 4; ++j) {
                    const int i = i0 + j * NGT;
                    if (i < SEQ * 64) {
                        const int t = i >> 6, rem = i & 63, h = rem >> 4, c8 = rem & 15;
                        const float m = fmaxf(l0[j], fmaxf(l1[j], l2[j]));
                        float w0 = __expf(l0[j] - m), w1 = __expf(l1[j] - m), w2 = __expf(l2[j] - m);
                        const float inv = 1.0f / (w0 + w1 + w2); w0 *= inv; w1 *= inv; w2 *= inv;
                        const u32x4 aa = a[j], bb = b[j], cc = c[j];
                        u32x4 o;
                        o.x = cvt_pk_bf16(w0 * bf_lo(aa.x) + w1 * bf_lo(bb.x) + w2 * bf_lo(cc.x), w0 * bf_hi(aa.x) + w1 * bf_hi(bb.x) + w2 * bf_hi(cc.x));
                        o.y = cvt_pk_bf16(w0 * bf_lo(aa.y) + w1 * bf_lo(bb.y) + w2 * bf_lo(cc.y), w0 * bf_hi(aa.y) + w1 * bf_hi(bb.y) + w2 * bf_hi(cc.y));
                        o.z = cvt_pk_bf16(w0 * bf_lo(aa.z) + w1 * bf_lo(bb.z) + w2 * bf_lo(cc.z), w0 * bf_hi(aa.z) + w1 * bf_hi(bb.z) + w2 * bf_hi(cc.z));
                        o.w = cvt_pk_bf16(w0 * bf_lo(aa.w) + w1 * bf_lo(bb.w) + w2 * bf_lo(cc.w), w0 * bf_hi(aa.w) + w1 * bf_hi(bb.w) + w2 * bf_hi(cc.w));
                        *(u32x4*)(CAT + (size_t)t * 1024 + h * 128 + c8 * 8) = o;
                    }
                }
            }
        } break;
        case K_GEMM_RES: if constexpr ((ENMASK >> 4) & 1) {
            pg8::Gemm g; pg8::EpiRes E{nullptr, H, SS};
            if (step == 4) { g = pg8::Gemm{CAT, WOUT0, SEQ, DM, 1024}; E.base32 = pp->x; }
            else if (step == 6) { g = pg8::Gemm{BIG, WDN, SEQ, DM, FF}; E.ss = SS + SEQ; }
            else if (step == 9) { g = pg8::Gemm{CAT, WOUT1, SEQ, DM, 2048}; E.ss = SS + 2 * SEQ; }
            else { g = pg8::Gemm{BIG, WDN + (size_t)2048 * 5632, SEQ, DM, FF}; E.ss = SS + 3 * SEQ; }
            pg8::Order S; S.init(SEQ, DM, G, bid, 0);
            pg8::gemm_phase<pg8::EpiRes>(lds, g, S, E);
        } break;
        case K_NORM: if constexpr ((ENMASK >> 5) & 1) {
            const int gw = bid * 8 + wave, NGW = G * 8;
            for (int m = gw; m < SEQ; m += NGW) {
                const float rstd = rsqrtf(fx_get(SS + 3 * SEQ + m) * (1.0f / 2048.0f) + 1e-6f);
                const u32x4* xr = (const u32x4*)(H + (size_t)m * DM) + lane; const f32x4* gr = (const f32x4*)pp->final_norm + 2 * lane; f32x4* orow = (f32x4*)(pp->out + (size_t)m * DM) + 2 * lane;
#pragma unroll
                for (int j = 0; j < 4; ++j) { const u32x4 w = __builtin_nontemporal_load(xr + 64 * j); const f32x4 g0 = gr[128 * j], g1 = gr[128 * j + 1];
                    __builtin_nontemporal_store((f32x4){bf_lo(w.x), bf_hi(w.x), bf_lo(w.y), bf_hi(w.y)} * rstd * g0, orow + 128 * j); __builtin_nontemporal_store((f32x4){bf_lo(w.z), bf_hi(w.z), bf_lo(w.w), bf_hi(w.w)} * rstd * g1, orow + 128 * j + 1); }
            }
        } break;
        case K_GEMM_GU: if constexpr ((ENMASK >> 6) & 1) {
            pg8::Gemm g{H, WGU + (size_t)layer * 11264 * 2048, SEQ, 11264, DM};
            pg8::Order S; S.init(SEQ, 11264, G, bid, 0);
            pg8::EpiGU E{BIG, SS + (layer ? 2 * SEQ : 0)};
            pg8::gemm_phase<pg8::EpiGU>(lds, g, S, E);
            if (rep == 0 && bid >= 128) {
                if (layer == 0) { cv_lo = CV_S7; cv_hi = CV_S5; } else { cv_lo = CV_S1; cv_hi = CV_END; }
                cv_w0 = (bid - 128) * 8 + wave; cv_nw = (G - 128) * 8;
            }
        } break;
        default: break;
        }
        if (cv_hi > cv_lo) convert_tiles(pp, ws, cv_lo, cv_hi, cv_w0, cv_nw, (LAS float*)(lds + wave * 16640), lane);
        if (step + 1 < NSTEPS || rep + 1 < nrep) {
#pragma unroll 1
            for (int sr = 0; sr < SYNC_REP; ++sr) xcd_barrier(xbar);
        }
        }
    }
}

extern "C" void kernel_launch(void* const* d_in, const int* in_sizes, int n_in, void* d_out, int out_size, void* d_ws, size_t ws_size, hipStream_t stream) {
    static int grid_blocks = 0;
    if (grid_blocks == 0) {
        if (n_in != 19 || ws_size < WS_NEED || out_size != SEQ * DM) { fprintf(stderr, "kernel_launch: unexpected problem (n_in %d, ws %zu need %zu, out %d)\n", n_in, ws_size, (size_t)WS_NEED, out_size); grid_blocks = -1; return; }
        int dev = 0, cus = 0, per_cu = 0;
        (void)hipGetDevice(&dev);
        (void)hipDeviceGetAttribute(&cus, hipDeviceAttributeMultiprocessorCount, dev);
        if (hipFuncSetAttribute((const void*)fwd_megakernel, hipFuncAttributeMaxDynamicSharedMemorySize, LDS_BYTES) != hipSuccess) { fprintf(stderr, "kernel_launch: hipFuncSetAttribute failed\n"); grid_blocks = -1; return; }
        if (hipOccupancyMaxActiveBlocksPerMultiprocessor(&per_cu, (const void*)fwd_megakernel, 512, LDS_BYTES) != hipSuccess || per_cu < 1) { fprintf(stderr, "kernel_launch: occupancy query failed (%d)\n", per_cu); grid_blocks = -1; return; }
        grid_blocks = cus * 1;
    }
    if (grid_blocks < 0) return;
    Params p{};
    p.x = (const float*)d_in[0]; p.mem = (const float*)d_in[1]; p.pos = (const int*)d_in[2];
    p.mix_norm = (const float*)d_in[3]; p.mem_norm = (const float*)d_in[4]; p.w_mem_kv = (const float*)d_in[5]; p.ffn_norm = (const float*)d_in[6];
    p.w_gate = (const float*)d_in[7]; p.w_up = (const float*)d_in[8]; p.w_down = (const float*)d_in[9];
    p.attn_w_in = (const float*)d_in[10]; p.attn_w_out = (const float*)d_in[11]; p.sgu_w_in = (const float*)d_in[12]; p.sgu_ln_g = (const float*)d_in[13]; p.sgu_ln_b = (const float*)d_in[14];
    p.sgu_w_spatial = (const float*)d_in[15]; p.sgu_b_spatial = (const float*)d_in[16]; p.sgu_w_out = (const float*)d_in[17]; p.final_norm = (const float*)d_in[18];
    p.out = (float*)d_out; p.ws = (unsigned char*)d_ws;
    if (hipMemsetAsync(d_ws, 0, BAR_BYTES, stream) != hipSuccess) { fprintf(stderr, "kernel_launch: memset failed\n"); return; }
    void* args[] = {&p};
    hipError_t e = hipLaunchCooperativeKernel((const void*)fwd_megakernel, dim3(grid_blocks), dim3(512), args, LDS_BYTES, stream);
    if (e != hipSuccess) fprintf(stderr, "kernel_launch: cooperative launch failed: %s (grid %d)\n", hipGetErrorString(e), grid_blocks);
}
```
